# Optimizing an MI355X kernel written in HIP

```python
import jax
import jax.numpy as jnp
from jax import lax
import numpy as np

D_MODEL = 1024
BATCH = 4
SEQ = 4096
DEPTH = 2

CTX_LEN = 256
GRID_W = 64
N_MOD = 6
EPS = 1e-6
N_EVEN = (DEPTH + 1) // 2
N_ODD = DEPTH // 2
LRU_WIDTH = D_MODEL
LRU_HEADS = 8
LRU_HEAD_DIM = LRU_WIDTH // LRU_HEADS
LRU_C = 8.0
CONV_W = 4
GLA_HEADS = 4
GLA_DK = D_MODEL // 2
GLA_DV = D_MODEL
GLA_RANK = 16
GLA_TAU = 16.0
HGRN_HEADS = 8
HGRN_DIM = D_MODEL
CHUNK = 64
N_EXPERTS = 64
TOP_K = 8
N_GROUPS = 8
TOPK_GROUPS = 4
EXPERT_FF = D_MODEL // 4
SHARED_FF = D_MODEL // 4
ROUTED_SCALE = 2.5
MOE_BLOCK = 128
AB_SIZES = (LRU_WIDTH, LRU_WIDTH, GLA_DK, GLA_DK, GLA_DV, GLA_DV, 2 * GLA_RANK)
C_SIZES = (HGRN_DIM,) * 5

kernel_name = 'hybrid_rglru_gla_hgrn2_moe_prefix_dit'


def split_cols(u, sizes):
    out, off = [], 0
    for s in sizes:
        out.append(u[..., off:off + s])
        off += s
    return out


def rmsnorm(t, gain):
    tf = t.astype(jnp.float32)
    tf = tf * lax.rsqrt(jnp.mean(tf * tf, axis=-1, keepdims=True) + EPS)
    return tf.astype(t.dtype) * gain


def head_rmsnorm(t):
    return t * lax.rsqrt(jnp.mean(t * t, axis=-1, keepdims=True) + EPS)


def to_heads(t, n_heads):
    b, s, _ = t.shape
    return t.reshape(b, s, n_heads, -1).transpose(0, 2, 1, 3)


def from_heads(t):
    b, h, s, d = t.shape
    return t.transpose(0, 2, 1, 3).reshape(b, s, h * d)


def grid_transpose(t, rows, cols):
    b, n, d = t.shape
    return t.reshape(b, rows, cols, d).transpose(0, 2, 1, 3).reshape(b, n, d)


def prefix_order(t_ctx, t_lat, reverse, axis):
    if reverse:
        t_ctx, t_lat = jnp.flip(t_ctx, axis), jnp.flip(t_lat, axis)
    return jnp.concatenate([t_ctx, t_lat], axis=axis)


def split_order(t, n_ctx, reverse, axis):
    t_ctx, t_lat = jnp.split(t, [n_ctx], axis=axis)
    if reverse:
        t_ctx, t_lat = jnp.flip(t_ctx, axis), jnp.flip(t_lat, axis)
    return t_ctx, t_lat


def centred_dwconv(t, w, b):
    s = t.shape[1]
    left = CONV_W // 2
    tp = jnp.pad(t, ((0, 0), (left, CONV_W - 1 - left), (0, 0)))
    return b + sum(tp[:, j:j + s] * w[j] for j in range(CONV_W))


def rglru_gates(xc, wa, ba, wi, bi, lam):
    b, s, _ = xc.shape
    xf = xc.astype(jnp.float32)
    xh = xf.reshape(b, s, LRU_HEADS, LRU_HEAD_DIM)
    r = jax.nn.sigmoid(jnp.einsum('bshd,hde->bshe', xh, wa.astype(jnp.float32)).reshape(b, s, LRU_WIDTH) + ba.astype(jnp.float32))
    i = jax.nn.sigmoid(jnp.einsum('bshd,hde->bshe', xh, wi.astype(jnp.float32)).reshape(b, s, LRU_WIDTH) + bi.astype(jnp.float32))
    log_a = -LRU_C * r * jax.nn.softplus(-lam.astype(jnp.float32))
    return jnp.exp(log_a), jnp.sqrt(-jnp.expm1(2.0 * log_a)) * (i * xf)


def linear_scan(a, u):
    def combine(l, r):
        return l[0] * r[0], r[0] * l[1] + r[1]
    return lax.associative_scan(combine, (a, u), axis=1)[1]


def chunked_gated_linear(q, k, v, log_a):
    bsz, nh, s, dk = q.shape
    dv = v.shape[-1]
    n = s // CHUNK
    qc = q.astype(jnp.float32).reshape(bsz, nh, n, CHUNK, dk)
    kc = k.astype(jnp.float32).reshape(bsz, nh, n, CHUNK, dk)
    vc = v.astype(jnp.float32).reshape(bsz, nh, n, CHUNK, dv)
    b = jnp.cumsum(log_a.astype(jnp.float32).reshape(bsz, nh, n, CHUNK, dk), axis=3)
    b_ref = b[:, :, :, CHUNK // 2 - 1:CHUNK // 2]
    b_last = b[:, :, :, -1:]
    scores = jnp.einsum('bhncd,bhnsd->bhncs', qc * jnp.exp(b - b_ref), kc * jnp.exp(b_ref - b))
    scores = jnp.where(jnp.tril(jnp.ones((CHUNK, CHUNK), dtype=bool)), scores, 0.0)
    o_intra = jnp.einsum('bhncs,bhnsv->bhncv', scores, vc)
    q_dec = qc * jnp.exp(b)
    k_dec = kc * jnp.exp(b_last - b)
    chunk_decay = jnp.exp(b[:, :, :, -1])

    def step(state, inp):
        qd, kd, vv, dec = inp
        o = jnp.einsum('bhcd,bhdv->bhcv', qd, state)
        state = dec[..., None] * state + jnp.einsum('bhcd,bhcv->bhdv', kd, vv)
        return state, o

    xs = tuple(jnp.moveaxis(t, 2, 0) for t in (q_dec, k_dec, vc, chunk_decay))
    _, o_inter = lax.scan(step, jnp.zeros((bsz, nh, dk, dv), jnp.float32), xs)
    return (o_intra + jnp.moveaxis(o_inter, 0, 2)).reshape(bsz, nh, s, dv)


def directional_chunked(q, k, v, g, n_ctx, reverse):
    ordered = [prefix_order(t_c, t_l, reverse, 2) for t_c, t_l in (q, k, v, g)]
    return split_order(chunked_gated_linear(*ordered), n_ctx, reverse, 2)


def gla_log_alpha(alr, wa2, ba):
    z = alr.astype(jnp.float32) @ wa2.astype(jnp.float32) + ba.astype(jnp.float32)
    return to_heads(jax.nn.log_sigmoid(z) / GLA_TAU, GLA_HEADS)


def mixer_ab(h_ctx, h_lat, w_in, conv_w, conv_b, lru_wa, lru_ba, lru_wi, lru_bi, lru_lambda,
             gla_wa2, gla_ba, w_out):
    n_ctx = h_ctx.shape[1]
    dt = h_lat.dtype
    cols = [split_cols(h @ w_in, AB_SIZES) for h in (h_ctx, h_lat)]
    conv = [centred_dwconv(cl[1], conv_w, conv_b) for cl in cols]
    rec = [0.0, 0.0]
    for d in range(2):
        rev = d == 1
        gates = [rglru_gates(xc, lru_wa[d], lru_ba[d], lru_wi[d], lru_bi[d], lru_lambda[d]) for xc in conv]
        a = prefix_order(gates[0][0], gates[1][0], rev, 1)
        u = prefix_order(gates[0][1], gates[1][1], rev, 1)
        hs = split_order(linear_scan(a, u), n_ctx, rev, 1)
        rec = [rec[j] + hs[j] for j in range(2)]
    y_a = [jax.nn.gelu(cl[0]) * r.astype(dt) for cl, r in zip(cols, rec)]
    q = tuple(to_heads(cl[2] * (GLA_DK // GLA_HEADS) ** -0.5, GLA_HEADS) for cl in cols)
    k = tuple(to_heads(cl[3], GLA_HEADS) for cl in cols)
    v = tuple(to_heads(cl[4], GLA_HEADS) for cl in cols)
    att = [0.0, 0.0]
    for d in range(2):
        g = tuple(gla_log_alpha(cl[6][..., d * GLA_RANK:(d + 1) * GLA_RANK], gla_wa2[d], gla_ba[d]) for cl in cols)
        o = directional_chunked(q, k, v, g, n_ctx, d == 1)
        att = [att[j] + o[j] for j in range(2)]
    y_b = [from_heads(head_rmsnorm(o)).astype(dt) * jax.nn.silu(cl[5]) for cl, o in zip(cols, att)]
    out_ctx = jnp.concatenate([y_a[0], y_b[0]], axis=-1) @ w_out
    out_lat = jnp.concatenate([y_a[1], y_b[1]], axis=-1) @ w_out
    return out_ctx, out_lat


def mixer_c(h_ctx, h_lat, layer, w_in, lb_logits, w_out):
    n_ctx = h_ctx.shape[1]
    dt = h_lat.dtype
    rows = h_lat.shape[1] // GRID_W
    h_lat = grid_transpose(h_lat, rows, GRID_W)
    lb_cum = jnp.cumsum(jax.nn.softmax(lb_logits.astype(jnp.float32), axis=0), axis=0)
    lb = lb_cum[layer] - lb_cum[0]
    log_lb, log_ub = jnp.log(lb), jnp.log1p(-lb)

    def forget(z):
        zf = z.astype(jnp.float32)
        log_f = jnp.logaddexp(log_lb, log_ub + jax.nn.log_sigmoid(zf))
        one_minus_f = jnp.exp(log_ub) * jax.nn.sigmoid(-zf)
        return to_heads(log_f, HGRN_HEADS), to_heads(one_minus_f, HGRN_HEADS)

    cols = [split_cols(h @ w_in, C_SIZES) for h in (h_ctx, h_lat)]
    q = tuple(to_heads(cl[0], HGRN_HEADS) for cl in cols)
    v = tuple(to_heads(cl[3], HGRN_HEADS) for cl in cols)
    acc = [0.0, 0.0]
    for d in range(2):
        fg = [forget(cl[1 + d]) for cl in cols]
        o = directional_chunked(q, (fg[0][1], fg[1][1]), v, (fg[0][0], fg[1][0]), n_ctx, d == 1)
        acc = [acc[j] + o[j] for j in range(2)]
    y = [from_heads(head_rmsnorm(o)).astype(dt) * jax.nn.silu(cl[4]) for cl, o in zip(cols, acc)]
    out_ctx = y[0] @ w_out
    out_lat = grid_transpose(y[1] @ w_out, GRID_W, rows)
    return out_ctx, out_lat


def swiglu(t, w_gate, w_up, w_down):
    return (jax.nn.silu(t @ w_gate) * (t @ w_up)) @ w_down


def moe_ffn(h, router, bias, w_gate, w_up, w_down, ws_gate, ws_up, ws_down):
    n_tok = h.shape[0]
    affinity = jax.nn.sigmoid(jnp.dot(h.astype(jnp.float32), router.astype(jnp.float32)))
    biased = affinity + bias.astype(jnp.float32)
    per_group = N_EXPERTS // N_GROUPS
    group_score = lax.top_k(biased.reshape(n_tok, N_GROUPS, per_group), 2)[0].sum(-1)
    _, top_groups = lax.top_k(group_score, TOPK_GROUPS)
    group_keep = jax.nn.one_hot(top_groups, N_GROUPS).sum(1) > 0
    expert_keep = jnp.repeat(group_keep, per_group, axis=1)
    _, top_e = lax.top_k(jnp.where(expert_keep, biased, -jnp.inf), TOP_K)
    gate = jnp.take_along_axis(affinity, top_e, axis=1)
    gate = ROUTED_SCALE * gate / jnp.sum(gate, axis=-1, keepdims=True)
    n_rows = n_tok * TOP_K
    n_blocks = -(-n_rows // MOE_BLOCK) + N_EXPERTS
    flat_e = top_e.reshape(-1)
    order = jnp.argsort(flat_e)
    sorted_e = flat_e[order]
    counts = jnp.bincount(flat_e, length=N_EXPERTS)
    padded = (counts + MOE_BLOCK - 1) // MOE_BLOCK * MOE_BLOCK
    ends = jnp.cumsum(padded)
    dest = (ends - padded)[sorted_e] + jnp.arange(n_rows) - (jnp.cumsum(counts) - counts)[sorted_e]
    row_tok = jnp.zeros((n_blocks * MOE_BLOCK,), jnp.int32).at[dest].set((order // TOP_K).astype(jnp.int32))
    row_w = jnp.zeros((n_blocks * MOE_BLOCK,), h.dtype).at[dest].set(gate.reshape(-1)[order].astype(h.dtype))
    block_e = jnp.minimum(jnp.searchsorted(ends, jnp.arange(n_blocks) * MOE_BLOCK, side='right'), N_EXPERTS - 1)

    def block_step(acc, blk):
        tok, wt, e = blk
        y = swiglu(h[tok], w_gate[e], w_up[e], w_down[e])
        return acc.at[tok].add(y * wt[:, None]), None

    shared = swiglu(h, ws_gate, ws_up, ws_down)
    out, _ = lax.scan(block_step, shared, (row_tok.reshape(n_blocks, MOE_BLOCK), row_w.reshape(n_blocks, MOE_BLOCK), block_e))
    return out


def setup_inputs(seed: int = 0) -> dict:
    key = jax.random.key(seed)
    keys = iter(jax.random.split(key, 40))

    def nrm(shape, scale):
        return scale * jax.random.normal(next(keys), shape, jnp.float32)

    ab_cols = sum(AB_SIZES)
    c_cols = sum(C_SIZES)
    a_pow = jax.random.uniform(next(keys), (N_EVEN, 2, LRU_WIDTH), jnp.float32, 0.9, 0.999)
    a_base = a_pow ** (1.0 / LRU_C)
    lru_lambda = jnp.log(a_base) - jnp.log1p(-a_base)
    return {
        'x': nrm((BATCH, SEQ, D_MODEL), 1.0),
        'c': nrm((BATCH, D_MODEL), 1.0),
        'ctx': nrm((BATCH, CTX_LEN, D_MODEL), 1.0),
        'c_ctx': nrm((D_MODEL,), 1.0),
        'mod_w': nrm((DEPTH, D_MODEL, N_MOD * D_MODEL), 0.5 * D_MODEL ** -0.5),
        'mod_b': nrm((DEPTH, N_MOD * D_MODEL), 0.02),
        'pre_gain': 1.0 + nrm((DEPTH, 2, D_MODEL), 0.1),
        'post_gain': 1.0 + nrm((DEPTH, 2, D_MODEL), 0.1),
        'ab_w_in': nrm((N_EVEN, D_MODEL, ab_cols), D_MODEL ** -0.5),
        'ab_conv_w': nrm((N_EVEN, CONV_W, LRU_WIDTH), CONV_W ** -0.5),
        'ab_conv_b': nrm((N_EVEN, LRU_WIDTH), 0.02),
        'ab_lru_wa': nrm((N_EVEN, 2, LRU_HEADS, LRU_HEAD_DIM, LRU_HEAD_DIM), LRU_HEAD_DIM ** -0.5),
        'ab_lru_ba': nrm((N_EVEN, 2, LRU_WIDTH), 0.02),
        'ab_lru_wi': nrm((N_EVEN, 2, LRU_HEADS, LRU_HEAD_DIM, LRU_HEAD_DIM), LRU_HEAD_DIM ** -0.5),
        'ab_lru_bi': nrm((N_EVEN, 2, LRU_WIDTH), 0.02),
        'ab_lru_lambda': lru_lambda,
        'ab_gla_wa2': nrm((N_EVEN, 2, GLA_RANK, GLA_DK), GLA_RANK ** -0.5),
        'ab_gla_ba': nrm((N_EVEN, 2, GLA_DK), 0.02),
        'ab_w_out': nrm((N_EVEN, LRU_WIDTH + GLA_DV, D_MODEL), (LRU_WIDTH + GLA_DV) ** -0.5),
        'c_w_in': nrm((N_ODD, D_MODEL, c_cols), D_MODEL ** -0.5),
        'hgrn_lb_logits': nrm((DEPTH, HGRN_DIM), 0.5),
        'c_w_out': nrm((N_ODD, HGRN_DIM, D_MODEL), HGRN_DIM ** -0.5),
        'moe_router': nrm((DEPTH, D_MODEL, N_EXPERTS), D_MODEL ** -0.5),
        'moe_bias': nrm((DEPTH, N_EXPERTS), 0.01),
        'moe_w_gate': nrm((DEPTH, N_EXPERTS, D_MODEL, EXPERT_FF), D_MODEL ** -0.5),
        'moe_w_up': nrm((DEPTH, N_EXPERTS, D_MODEL, EXPERT_FF), D_MODEL ** -0.5),
        'moe_w_down': nrm((DEPTH, N_EXPERTS, EXPERT_FF, D_MODEL), EXPERT_FF ** -0.5),
        'moe_ws_gate': nrm((DEPTH, D_MODEL, SHARED_FF), D_MODEL ** -0.5),
        'moe_ws_up': nrm((DEPTH, D_MODEL, SHARED_FF), D_MODEL ** -0.5),
        'moe_ws_down': nrm((DEPTH, SHARED_FF, D_MODEL), SHARED_FF ** -0.5),
    }


def reference(x, c, ctx, c_ctx, mod_w, mod_b, pre_gain, post_gain,
              ab_w_in, ab_conv_w, ab_conv_b, ab_lru_wa, ab_lru_ba, ab_lru_wi, ab_lru_bi, ab_lru_lambda,
              ab_gla_wa2, ab_gla_ba, ab_w_out, c_w_in, hgrn_lb_logits, c_w_out,
              moe_router, moe_bias, moe_w_gate, moe_w_up, moe_w_down, moe_ws_gate, moe_ws_up, moe_ws_down):
    silu_c = jax.nn.silu(c)
    silu_cc = jax.nn.silu(c_ctx)
    n_tok_ctx = ctx.shape[0] * ctx.shape[1]
    for layer in range(DEPTH):
        last = layer == DEPTH - 1
        p = layer // 2
        m_l = jnp.split((silu_c @ mod_w[layer] + mod_b[layer])[:, None, :], N_MOD, axis=-1)
        m_c = jnp.split(silu_cc @ mod_w[layer] + mod_b[layer], N_MOD, axis=-1)
        h_c = rmsnorm(ctx, pre_gain[layer, 0]) * (1.0 + m_c[1]) + m_c[0]
        h_l = rmsnorm(x, pre_gain[layer, 0]) * (1.0 + m_l[1]) + m_l[0]
        if layer % 2 == 0:
            o_c, o_l = mixer_ab(h_c, h_l, ab_w_in[p], ab_conv_w[p], ab_conv_b[p], ab_lru_wa[p], ab_lru_ba[p],
                                ab_lru_wi[p], ab_lru_bi[p], ab_lru_lambda[p], ab_gla_wa2[p], ab_gla_ba[p], ab_w_out[p])
        else:
            o_c, o_l = mixer_c(h_c, h_l, layer, c_w_in[p], hgrn_lb_logits, c_w_out[p])
        x = x + m_l[2] * rmsnorm(o_l, post_gain[layer, 0])
        moe_p = (moe_router[layer], moe_bias[layer], moe_w_gate[layer], moe_w_up[layer], moe_w_down[layer],
                 moe_ws_gate[layer], moe_ws_up[layer], moe_ws_down[layer])
        h_l = rmsnorm(x, pre_gain[layer, 1]) * (1.0 + m_l[4]) + m_l[3]
        if last:
            f_l = moe_ffn(h_l.reshape(-1, D_MODEL), *moe_p).reshape(x.shape)
        else:
            ctx = ctx + m_c[2] * rmsnorm(o_c, post_gain[layer, 0])
            h_c = rmsnorm(ctx, pre_gain[layer, 1]) * (1.0 + m_c[4]) + m_c[3]
            f = moe_ffn(jnp.concatenate([h_c.reshape(-1, D_MODEL), h_l.reshape(-1, D_MODEL)], axis=0), *moe_p)
            ctx = ctx + m_c[5] * rmsnorm(f[:n_tok_ctx].reshape(ctx.shape), post_gain[layer, 1])
            f_l = f[n_tok_ctx:].reshape(x.shape)
        x = x + m_l[5] * rmsnorm(f_l, post_gain[layer, 1])
    return x
```

```cpp
#define MK_DEBUG 0
#define MK_NPHASE 22
#define MK_DEBUG_FULL 1
#define MK_DEBUG_THR 1e-3f
#define MK_EXTRA
#define MK_PRE
#define MK_ABL 0
#define MK_XBAR 0
#include <hip/hip_runtime.h>
#include <cstdio>
#include <cstdint>

constexpr int D = 1024, NB = 4, SEQ = 4096, CTX = 256, T = SEQ + CTX  , R = NB * T  ;
constexpr int NE = 64, TOPK = 8, FF = 256, NMOD = 6 * D;
constexpr int ABC = 5152, CC = 5120;
constexpr int NCH = T / 64;
constexpr float EPS = 1e-6f;

#define GAS __attribute__((address_space(1)))
#define LAS __attribute__((address_space(3)))
typedef unsigned short bf16;
typedef unsigned short f16b;
typedef unsigned v4u __attribute__((ext_vector_type(4)));
typedef unsigned v2u __attribute__((ext_vector_type(2)));
typedef float f32x4 __attribute__((ext_vector_type(4)));
typedef float f32x2 __attribute__((ext_vector_type(2)));
typedef float f32x16 __attribute__((ext_vector_type(16)));
typedef short bf16x8 __attribute__((ext_vector_type(8)));
typedef _Float16 h2_t __attribute__((ext_vector_type(2)));

typedef __bf16 bf2_t __attribute__((ext_vector_type(2)));
__device__ __forceinline__ unsigned pk2(float lo, float hi) { const f32x2 v = {lo, hi}; return __builtin_bit_cast(unsigned, __builtin_convertvector(v, bf2_t)); }
__device__ __forceinline__ unsigned f2bf(float f) { return pk2(f, f) & 0xffffu; }
__device__ __forceinline__ float bf2f(unsigned b) { return __builtin_bit_cast(float, b << 16); }
__device__ __forceinline__ unsigned cvt_pk_bf16(float lo, float hi) { return pk2(lo, hi); }
__device__ __forceinline__ unsigned hwpk2(float lo, float hi) { return pk2(lo, hi); }
__device__ __forceinline__ unsigned short hwbf(float v) { return (unsigned short)pk2(v, v); }
__device__ __forceinline__ float clamp448(float v) { return __builtin_amdgcn_fmed3f(v, -448.f, 448.f); }
__device__ __forceinline__ unsigned pk4f8(float a, float b, float c, float d) { int w = __builtin_amdgcn_cvt_pk_fp8_f32(clamp448(a), clamp448(b), 0, false); w = __builtin_amdgcn_cvt_pk_fp8_f32(clamp448(c), clamp448(d), w, true); return (unsigned)w; }
__device__ __forceinline__ unsigned pk2h(float lo, float hi) { h2_t v; v.x = (_Float16)lo; v.y = (_Float16)hi; return __builtin_bit_cast(unsigned, v); }
__device__ __forceinline__ float h2f(unsigned short h) { return (float)__builtin_bit_cast(_Float16, h); }
__device__ __forceinline__ float bflo(unsigned w) { return __builtin_bit_cast(float, w << 16); }
__device__ __forceinline__ float bfhi(unsigned w) { return __builtin_bit_cast(float, w & 0xffff0000u); }
__device__ __forceinline__ float fexp(float x) { return __builtin_amdgcn_exp2f(x * 1.4426950408889634f); }
__device__ __forceinline__ float frcp(float x) { return __builtin_amdgcn_rcpf(x); }
__device__ __forceinline__ float fsigm(float x) { return frcp(1.f + fexp(-x)); }
__device__ __forceinline__ float fsilu(float x) { return x * frcp(1.f + fexp(-x)); }
__device__ __forceinline__ float fgelu(float x) { const float u = 1.5957691216057308f * (x + 0.044715f * x * x * x); return x * frcp(1.f + fexp(-u)); }
#define LDS_WAIT() asm volatile("s_waitcnt lgkmcnt(0)" ::: "memory")
#define VM_WAIT() asm volatile("s_waitcnt vmcnt(0)" ::: "memory")

__device__ __forceinline__ const float* row_src(const float* xl, const float* xc, int row) {
    const int b = row / T, s = row % T;
    return s < CTX ? xc + ((size_t)b * CTX + s) * D : xl + ((size_t)b * SEQ + (s - CTX)) * D;
}
__device__ __forceinline__ float* row_dst(float* xl, float* xc, int row) {
    const int b = row / T, s = row % T;
    return s < CTX ? xc + ((size_t)b * CTX + s) * D : xl + ((size_t)b * SEQ + (s - CTX)) * D;
}
__device__ __forceinline__ int scan_pos(int i, int rev, int perm) {
    int p;
    if (!rev) p = i; else p = (i < CTX) ? (CTX - 1 - i) : (CTX + (SEQ - 1 - (i - CTX)));
    if (p < CTX || !perm) return p;
    const int q = p - CTX, c = q >> 6, r = q & 63;
    return CTX + r * 64 + c;
}
__device__ __forceinline__ float wave_sum(float v) {
#pragma unroll
    for (int o = 32; o >= 1; o >>= 1) v += __shfl_xor(v, o);
    return v;
}
__device__ __forceinline__ float sigm(float x) { return 1.f / (1.f + expf(-x)); }
__device__ __forceinline__ float siluf(float x) { return x / (1.f + expf(-x)); }
__device__ __forceinline__ float logsigm(float x) { return fminf(x, 0.f) - log1pf(expf(-fabsf(x))); }
__device__ __forceinline__ float gelu_tanh(float x) { return 0.5f * x * (1.f + tanhf(0.7978845608028654f * (x + 0.044715f * x * x * x))); }

#if MK_DEBUG
namespace nv {
__global__ void k_mod(const float* c, const float* cctx, const float* mod_w, const float* mod_b, float* M) {
    const int n = blockIdx.x * 256 + threadIdx.x, r = blockIdx.y, l = blockIdx.z;
    const float* v = r < 4 ? c + r * D : cctx;
    __shared__ float sv[D];
    for (int k = threadIdx.x; k < D; k += 256) sv[k] = siluf(v[k]);
    __syncthreads();
    const float* W = mod_w + (size_t)l * D * NMOD;
    float acc = 0.f;
    for (int k = 0; k < D; ++k) acc += sv[k] * W[(size_t)k * NMOD + n];
    M[(size_t)(l * 5 + r) * NMOD + n] = acc + mod_b[l * NMOD + n];
}
__device__ __forceinline__ float block_sum256(float v, float* red) {
    v = wave_sum(v);
    if ((threadIdx.x & 63) == 0) red[threadIdx.x >> 6] = v;
    __syncthreads();
    const float t = red[0] + red[1] + red[2] + red[3];
    __syncthreads();
    return t;
}
__global__ void k_prenorm(const float* xl, const float* xc, const float* gain, const float* Ml, int shift_i, int scale_i, float* H, int row0) {
    __shared__ float red[4];
    const int row = row0 + blockIdx.x, b = row / T, s = row % T;
    const float* src = row_src(xl, xc, row);
    const float* m = Ml + (size_t)(s < CTX ? 4 : b) * NMOD;
    float v[4], ss = 0.f;
#pragma unroll
    for (int i = 0; i < 4; ++i) { v[i] = src[threadIdx.x + 256 * i]; ss += v[i] * v[i]; }
    const float rstd = rsqrtf(block_sum256(ss, red) * (1.f / D) + EPS);
#pragma unroll
    for (int i = 0; i < 4; ++i) { const int c = threadIdx.x + 256 * i;
        H[(size_t)row * D + c] = v[i] * rstd * gain[c] * (1.f + m[scale_i * D + c]) + m[shift_i * D + c]; }
}
__global__ void k_postres(const float* sl, const float* sc, float* dl, float* dc, const float* O, const float* pgain, const float* Ml, int gate_i, int row0, int lat_only) {
    __shared__ float red[4];
    int row = row0 + blockIdx.x;
    if (lat_only) { const int b = blockIdx.x / SEQ, t = blockIdx.x % SEQ; row = b * T + CTX + t; }
    const int b = row / T, s = row % T;
    const float* src = row_src(sl, sc, row); float* dst = row_dst(dl, dc, row);
    const float* m = Ml + (size_t)(s < CTX ? 4 : b) * NMOD;
    float v[4], ss = 0.f;
#pragma unroll
    for (int i = 0; i < 4; ++i) { v[i] = O[(size_t)row * D + threadIdx.x + 256 * i]; ss += v[i] * v[i]; }
    const float rstd = rsqrtf(block_sum256(ss, red) * (1.f / D) + EPS);
#pragma unroll
    for (int i = 0; i < 4; ++i) { const int c = threadIdx.x + 256 * i;
        dst[c] = src[c] + m[gate_i * D + c] * (v[i] * rstd * pgain[c]); }
}
__global__ void k_gemm(const float* A, int lda, const float* B, int ldb, float* C, int ldc, int M, int N, int K) {
    __shared__ float As[16][68], Bs[16][68];
    const int tid = threadIdx.x, tx = tid & 15, ty = tid >> 4, m0 = blockIdx.y * 64, n0 = blockIdx.x * 64;
    float acc[4][4];
#pragma unroll
    for (int i = 0; i < 4; ++i)
#pragma unroll
        for (int j = 0; j < 4; ++j) acc[i][j] = 0.f;
    for (int k0 = 0; k0 < K; k0 += 16) {
#pragma unroll
        for (int i = 0; i < 4; ++i) {
            const int idx = tid + 256 * i;
            { const int r = idx >> 4, kk = idx & 15; As[kk][r] = (m0 + r < M) ? A[(size_t)(m0 + r) * lda + k0 + kk] : 0.f; }
            { const int kk = idx >> 6, cc = idx & 63; Bs[kk][cc] = (n0 + cc < N) ? B[(size_t)(k0 + kk) * ldb + n0 + cc] : 0.f; }
        }
        __syncthreads();
#pragma unroll
        for (int kk = 0; kk < 16; ++kk) {
            float a[4], b[4];
#pragma unroll
            for (int i = 0; i < 4; ++i) { a[i] = As[kk][ty * 4 + i]; b[i] = Bs[kk][tx * 4 + i]; }
#pragma unroll
            for (int i = 0; i < 4; ++i)
#pragma unroll
                for (int j = 0; j < 4; ++j) acc[i][j] += a[i] * b[j];
        }
        __syncthreads();
    }
#pragma unroll
    for (int i = 0; i < 4; ++i)
#pragma unroll
        for (int j = 0; j < 4; ++j) { const int m = m0 + ty * 4 + i, n = n0 + tx * 4 + j; if (m < M && n < N) C[(size_t)m * ldc + n] = acc[i][j]; }
}
__global__ void k_conv(const float* X, const float* w, const float* bias, float* Y) {
    const size_t i = (size_t)blockIdx.x * 256 + threadIdx.x; if (i >= (size_t)R * D) return;
    const int row = (int)(i / D), c = (int)(i % D), b = row / T, s = row % T;
    const int lo = s < CTX ? 0 : CTX, hi = s < CTX ? CTX : T;
    float acc = bias[c];
#pragma unroll
    for (int j = 0; j < 4; ++j) { const int ss = s + j - 2; if (ss >= lo && ss < hi) acc += w[j * D + c] * X[((size_t)b * T + ss) * D + c]; }
    Y[i] = acc;
}
__global__ void k_lru_gate(float* RA, float* RI, const float* conv, const float* ba, const float* bi, const float* lam) {
    const size_t i = (size_t)blockIdx.x * 256 + threadIdx.x; if (i >= (size_t)R * D) return;
    const int c = (int)(i % D);
    const float r = sigm(RA[i] + ba[c]), g = sigm(RI[i] + bi[c]);
    const float log_a = -8.f * r * log1pf(expf(-lam[c]));
    RA[i] = expf(log_a); RI[i] = sqrtf(-expm1f(2.f * log_a)) * (g * conv[i]);
}
__global__ void k_lru_scan(const float* Aa, const float* U, float* rec, int rev, int accumulate) {
    const int g = blockIdx.x * 256 + threadIdx.x; if (g >= NB * D) return;
    const int b = g / D, c = g % D;
    float h = 0.f;
    for (int i = 0; i < T; ++i) {
        const size_t o = ((size_t)b * T + scan_pos(i, rev, 0)) * D + c;
        h = Aa[o] * h + U[o];
        rec[o] = accumulate ? rec[o] + h : h;
    }
}
__global__ void k_ya(const float* G, const float* rec, float* Y, int ldy) {
    const size_t i = (size_t)blockIdx.x * 256 + threadIdx.x; if (i >= (size_t)R * D) return;
    const int row = (int)(i / D), c = (int)(i % D);
    Y[(size_t)row * ldy + c] = gelu_tanh(G[i]) * rec[i];
}
__global__ void k_scale(float* X, size_t n, float s) { const size_t i = (size_t)blockIdx.x * 256 + threadIdx.x; if (i < n) X[i] *= s; }
__global__ void k_gla_gate(float* G, const float* bias, int ncol) {
    const size_t i = (size_t)blockIdx.x * 256 + threadIdx.x; if (i >= (size_t)R * ncol) return;
    G[i] = logsigm(G[i] + bias[i % ncol]) * (1.f / 16.f);
}
__global__ void k_hgrn_gate(const float* Z, int ldz, const float* lbl, float* LG, float* KK) {
    const size_t i = (size_t)blockIdx.x * 256 + threadIdx.x; if (i >= (size_t)R * D) return;
    const int row = (int)(i / D), c = (int)(i % D);
    const float l0 = lbl[c], l1 = lbl[D + c], mx = fmaxf(l0, l1), e0 = expf(l0 - mx), e1 = expf(l1 - mx), lb = e1 / (e0 + e1);
    const float z = Z[(size_t)row * ldz + c];
    const float f = lb + (1.f - lb) * sigm(z);
    LG[i] = logf(f); KK[i] = (1.f - lb) * sigm(-z);
}
template <int DVH> __global__ void __launch_bounds__(1024) k_gla_scan(const float* q, int ldq, const float* k, int ldk, const float* v, int ldv, const float* g, int ldg, float* o, int ldo, int rev, int perm, int accumulate) {
    __shared__ float red[16];
    const int tid = threadIdx.x, d = tid & 127, el = tid >> 7, e = blockIdx.x * 8 + el, h = blockIdx.y, b = blockIdx.z, wv = tid >> 6;
    float S = 0.f;
    size_t row = (size_t)b * T + scan_pos(0, rev, perm);
    float gg = g[row * ldg + h * 128 + d], kk = k[row * ldk + h * 128 + d], vv = v[row * ldv + h * DVH + e], qq = q[row * ldq + h * 128 + d];
    for (int i = 0; i < T; ++i) {
        const size_t crow = row; const float cg = gg, ck = kk, cv = vv, cq = qq;
        if (i + 1 < T) { row = (size_t)b * T + scan_pos(i + 1, rev, perm);
            gg = g[row * ldg + h * 128 + d]; kk = k[row * ldk + h * 128 + d]; vv = v[row * ldv + h * DVH + e]; qq = q[row * ldq + h * 128 + d]; }
        S = expf(cg) * S + ck * cv;
        const float p = wave_sum(cq * S);
        if ((tid & 63) == 0) red[wv] = p;
        __syncthreads();
        if (d == 0) { const float t = red[2 * el] + red[2 * el + 1]; float* op = o + crow * ldo + h * DVH + e; *op = accumulate ? *op + t : t; }
        __syncthreads();
    }
}
template <int DVH> __global__ void k_yb(const float* att, const float* gate, int ldg, float* Y, int ldy, int nheads) {
    const int wid = (blockIdx.x * 256 + threadIdx.x) >> 6, lane = threadIdx.x & 63;
    if (wid >= R * nheads) return;
    const int row = wid / nheads, h = wid % nheads;
    float v[DVH / 64], ss = 0.f;
#pragma unroll
    for (int i = 0; i < DVH / 64; ++i) { v[i] = att[(size_t)row * (nheads * DVH) + h * DVH + lane + 64 * i]; ss += v[i] * v[i]; }
    const float rstd = rsqrtf(wave_sum(ss) * (1.f / DVH) + EPS);
#pragma unroll
    for (int i = 0; i < DVH / 64; ++i) { const int c = h * DVH + lane + 64 * i; Y[(size_t)row * ldy + c] = v[i] * rstd * siluf(gate[(size_t)row * ldg + c]); }
}
__global__ void k_route(const float* logits, const float* bias, int ntok, int* tk_e, float* tk_w, int* cnt, int* list) {
    const int t = (blockIdx.x * 256 + threadIdx.x) >> 6, e = threadIdx.x & 63;
    if (t >= ntok) return;
    const float aff = sigm(logits[(size_t)t * NE + e]), bs = aff + bias[e];
    int rk = 0;
#pragma unroll
    for (int j = 0; j < 8; ++j) { const int o = (e & ~7) + j; const float x = __shfl(bs, o); rk += (x > bs || (x == bs && o < e)) ? 1 : 0; }
    float gs = rk < 2 ? bs : 0.f;
    gs += __shfl_xor(gs, 1); gs += __shfl_xor(gs, 2); gs += __shfl_xor(gs, 4);
    int grk = 0; const int gi = e >> 3;
#pragma unroll
    for (int j = 0; j < 8; ++j) { const float x = __shfl(gs, j * 8); grk += (x > gs || (x == gs && j < gi)) ? 1 : 0; }
    const bool keep = grk < 4;
    const float mv = keep ? bs : -INFINITY;
    int erk = 0;
    for (int j = 0; j < 64; ++j) { const float x = __shfl(mv, j); erk += (x > mv || (x == mv && j < e)) ? 1 : 0; }
    const bool sel = keep && erk < TOPK;
    const float ssum = wave_sum(sel ? aff : 0.f);
    if (sel) {
        tk_e[(size_t)t * TOPK + erk] = e; tk_w[(size_t)t * TOPK + erk] = 2.5f * aff / ssum;
        const int pos = atomicAdd(&cnt[e], 1);
        list[(size_t)e * R + pos] = t * TOPK + erk;
    }
}
__global__ void k_expert(const float* H, int tok_row0  , int ntok, const float* Wg, const float* Wu, const float* Wd, const int* cnt, const int* list, const float* tk_w, int e, float* F, int assign) {
    __shared__ float hs[8][D];
    __shared__ float as[8][FF];
    __shared__ int tok[8]; __shared__ float wt[8];
    const int tid = threadIdx.x, n_rows = (e < NE) ? cnt[e] : ntok, p0 = blockIdx.x * 8;
    if (p0 >= n_rows) return;
    if (tid < 8) { const int p = p0 + tid; int tk = -1; float w = 0.f;
        if (p < n_rows) { if (e < NE) { const int slot = list[(size_t)e * R + p]; tk = slot / TOPK; w = tk_w[slot]; } else { tk = p; w = 1.f; } }
        tok[tid] = tk; wt[tid] = w; }
    __syncthreads();
#pragma unroll
    for (int r = 0; r < 8; ++r) { const int tk = tok[r];
#pragma unroll
        for (int i = 0; i < 4; ++i) hs[r][tid + 256 * i] = tk >= 0 ? H[(size_t)(tok_row0 + tk) * D + tid + 256 * i] : 0.f; }
    __syncthreads();
    float ag[8], au[8];
#pragma unroll
    for (int r = 0; r < 8; ++r) { ag[r] = 0.f; au[r] = 0.f; }
    for (int k = 0; k < D; ++k) { const float wg = Wg[(size_t)k * FF + tid], wu = Wu[(size_t)k * FF + tid];
#pragma unroll
        for (int r = 0; r < 8; ++r) { const float hv = hs[r][k]; ag[r] += hv * wg; au[r] += hv * wu; } }
#pragma unroll
    for (int r = 0; r < 8; ++r) as[r][tid] = siluf(ag[r]) * au[r];
    __syncthreads();
    float acc[8][4];
#pragma unroll
    for (int r = 0; r < 8; ++r)
#pragma unroll
        for (int c = 0; c < 4; ++c) acc[r][c] = 0.f;
    for (int j = 0; j < FF; ++j) { float w[4];
#pragma unroll
        for (int c = 0; c < 4; ++c) w[c] = Wd[(size_t)j * D + tid + 256 * c];
#pragma unroll
        for (int r = 0; r < 8; ++r) { const float a = as[r][j];
#pragma unroll
            for (int c = 0; c < 4; ++c) acc[r][c] += a * w[c]; } }
#pragma unroll
    for (int r = 0; r < 8; ++r) { const int tk = tok[r]; if (tk < 0) continue; const float w = wt[r];
#pragma unroll
        for (int c = 0; c < 4; ++c) { float* fp = F + (size_t)tk * D + tid + 256 * c; *fp = assign ? w * acc[r][c] : *fp + w * acc[r][c]; } }
}
}

#endif

namespace pg8 {
constexpr int BM = 256, BK = 64, HALF = 128, HTB = HALF * BK * 2  , STAGE_BYTES = 8 * HTB, NXCD = 8, WGM = 8;
__device__ __forceinline__ int lds_byte(int r, int c) { const int st = (r >> 4) * 2 + (c >> 5), rr = r & 15, cc = c & 31, ob = rr * 64 + cc * 2; return st * 1024 + (ob ^ (((ob >> 9) & 1) << 5)); }
__device__ __forceinline__ void stage_rc(int b, int& R_, int& C_) { const int st = b / 1024, sb = b % 1024, swz = sb ^ (((sb >> 9) & 1) << 5); R_ = (st >> 1) * 16 + swz / 64; C_ = (st & 1) * 32 + (swz % 64) / 2; }
__device__ __forceinline__ int perm32(int rho) { const int n = rho >> 4, i = rho & 15; return 8 * (i >> 2) + 4 * n + (i & 3); }

struct Unit { int pm, pn, e, arow0; };

__device__ __forceinline__ int xcd_remap(int L, int nU) { const int q = nU / NXCD, r = nU % NXCD, xcd = L % NXCD, off = L / NXCD; return (xcd < r ? xcd * (q + 1) : r * (q + 1) + (xcd - r) * q) + off; }

typedef int v8i __attribute__((ext_vector_type(8)));
typedef int v4i __attribute__((ext_vector_type(4)));
template <class Epi, class Sched, bool F8 = false>
__device__ __forceinline__ void gemm_phase(LAS unsigned char* lds, const int K, const Sched& S, const Epi& E) {
    const int tid = threadIdx.x, wid = __builtin_amdgcn_readfirstlane(tid >> 6), lane = tid & 63, wr = wid >> 2, wc = wid & 3, fr = lane & 15, fq = lane >> 4;
    const int nt = K / BK;
    unsigned voffB[2];
#pragma unroll
    for (int i = 0; i < 2; ++i) { int R_, C_; stage_rc(tid * 16 + i * 8192, R_, C_); const int Rb = (R_ & ~31) + perm32(R_ & 31); voffB[i] = (unsigned)(Rb * K + C_) * 2u; }
    const size_t kstep = (size_t)(BK * 2);
    const size_t hstep = (size_t)HALF * K * 2;
    const unsigned ldsw = (unsigned)wid * 1024u;
    const int aoff = lds_byte(wr * 64 + fr, fq * 8), boff = lds_byte(wc * 32 + fr, fq * 8);
    const int aoff8a = lds_byte(wr * 64 + fr, fq * 16), boff8a = lds_byte(wc * 32 + fr, fq * 16);
#define PG8_SA(b, h) (((b) * 2 + (h)) * HTB)
#define PG8_SB(b, h) ((4 + (b) * 2 + (h)) * HTB)
#define PG8_STAGE(bufoff, gbase, voff) do { _Pragma("unroll") for (int _i = 0; _i < 2; ++_i) \
        __builtin_amdgcn_global_load_lds((const unsigned*)((const char*)(gbase) + (voff)[_i]), (LAS unsigned*)(lds + (bufoff) + ldsw + _i * 8192), 16, 0, 0); } while (0)
#define PG8_LDA(dst, b, h) do { _Pragma("unroll") for (int m = 0; m < 4; ++m) { if constexpr (F8) { const v4i lo_ = *(const LAS v4i*)(lds + PG8_SA(b, h) + aoff8a + m * 2048), hi_ = *(const LAS v4i*)(lds + PG8_SA(b, h) + aoff8a + m * 2048 + 16); \
            dst##8[m] = __builtin_shufflevector(lo_, hi_, 0, 1, 2, 3, 4, 5, 6, 7); } \
        else { _Pragma("unroll") for (int k = 0; k < 2; ++k) dst[m][k] = *(const LAS bf16x8*)(lds + PG8_SA(b, h) + aoff + m * 2048 + k * 1024); } } } while (0)
#define PG8_LDB(dst, b, h) do { _Pragma("unroll") for (int n = 0; n < 2; ++n) { if constexpr (F8) { const v4i lo_ = *(const LAS v4i*)(lds + PG8_SB(b, h) + boff8a + n * 2048), hi_ = *(const LAS v4i*)(lds + PG8_SB(b, h) + boff8a + n * 2048 + 16); \
            dst##8[n] = __builtin_shufflevector(lo_, hi_, 0, 1, 2, 3, 4, 5, 6, 7); } \
        else { _Pragma("unroll") for (int k = 0; k < 2; ++k) dst[n][k] = *(const LAS bf16x8*)(lds + PG8_SB(b, h) + boff + n * 2048 + k * 1024); } } } while (0)
#define PG8_MMA(ai, bj, At, Bt) do { __builtin_amdgcn_s_setprio(1); _Pragma("unroll") for (int m = 0; m < 4; ++m) _Pragma("unroll") for (int n = 0; n < 2; ++n) { \
        if constexpr (F8) acc[ai][bj][m][n] = __builtin_amdgcn_mfma_scale_f32_16x16x128_f8f6f4(Bt##8[n], At##8[m], acc[ai][bj][m][n], 0, 0, 0, 0x7C7C7C7C, 0, 0x7C7C7C7C);     \
        else { _Pragma("unroll") for (int k = 0; k < 2; ++k) acc[ai][bj][m][n] = __builtin_amdgcn_mfma_f32_16x16x32_bf16(Bt[n][k], At[m][k], acc[ai][bj][m][n], 0, 0, 0); } } \
        __builtin_amdgcn_s_setprio(0); } while (0)
#define PG8_WAIT_V(n) asm volatile("s_waitcnt vmcnt(" #n ")" ::: "memory")
#define PG8_WAIT_L(n) asm volatile("s_waitcnt lgkmcnt(" #n ")" ::: "memory")
#define PG8_BAR __builtin_amdgcn_s_barrier()
#define PG8_SCHED __builtin_amdgcn_sched_barrier(0)
    Unit cur, nxt; int ui = 0;
    if (!S.next(0, cur)) return;
    f32x4 acc[2][2][4][2];
#pragma unroll
    for (int a = 0; a < 2; ++a)
#pragma unroll
        for (int b = 0; b < 2; ++b)
#pragma unroll
            for (int m = 0; m < 4; ++m)
#pragma unroll
                for (int n = 0; n < 2; ++n) acc[a][b][m][n] = (f32x4){0.f, 0.f, 0.f, 0.f};
    bf16x8 At[4][2], B0[2][2], B1[2][2];
    v8i At8[4], B08[2], B18[2];
    unsigned vA[2][2], vN[2][2];
    S.a_offs(cur, vA, tid);
    const char* const Ab = S.a_base();
    const char* cB = S.b_base(cur);
    PG8_STAGE(PG8_SB(0, 0), cB, voffB); PG8_STAGE(PG8_SB(0, 1), cB + hstep, voffB); PG8_STAGE(PG8_SA(0, 0), Ab, vA[0]); PG8_STAGE(PG8_SA(0, 1), Ab, vA[1]);
    if (wr == 1) PG8_BAR;
    PG8_WAIT_V(2); PG8_BAR;
    PG8_STAGE(PG8_SB(1, 0), cB + kstep, voffB); PG8_STAGE(PG8_SA(1, 0), Ab + kstep, vA[0]); PG8_STAGE(PG8_SB(1, 1), cB + hstep + kstep, voffB);
    PG8_WAIT_V(6); PG8_BAR;
    for (;;) {
        const bool has_next = S.next(ui + 1, nxt);
        const char* nB = has_next ? S.b_base(nxt) : cB;
        if (has_next) S.a_offs(nxt, vN, tid);
        else { vN[0][0] = vA[0][0]; vN[0][1] = vA[0][1]; vN[1][0] = vA[1][0]; vN[1][1] = vA[1][1]; }
        for (int t = 0; t < nt; t += 2) {
            const bool last = (t == nt - 2);
            const char* a1 = Ab + (size_t)(t + 1) * kstep;
            PG8_LDB(B0, 0, 0); PG8_LDB(B1, 0, 1); PG8_SCHED; PG8_LDA(At, 0, 0); PG8_STAGE(PG8_SA(1, 1), a1, vA[1]);
            PG8_WAIT_V(8); PG8_WAIT_L(0); PG8_BAR; PG8_MMA(0, 0, At, B0); PG8_MMA(0, 1, At, B1); PG8_BAR; PG8_SCHED;
            const char* a2; const char* b2;
            if (last) { vA[0][0] = vN[0][0]; vA[0][1] = vN[0][1]; vA[1][0] = vN[1][0]; vA[1][1] = vN[1][1]; a2 = Ab; b2 = nB; }
            else { a2 = Ab + (size_t)(t + 2) * kstep; b2 = cB + (size_t)(t + 2) * kstep; }
            const char* a3 = a2 + kstep; const char* b3 = b2 + kstep;
            PG8_LDA(At, 0, 1); PG8_STAGE(PG8_SB(0, 0), b2, voffB); PG8_STAGE(PG8_SB(0, 1), b2 + hstep, voffB); PG8_STAGE(PG8_SA(0, 0), a2, vA[0]);
            PG8_WAIT_V(8); PG8_WAIT_L(0); PG8_BAR; PG8_MMA(1, 0, At, B0); PG8_MMA(1, 1, At, B1); PG8_BAR; PG8_SCHED;
            PG8_LDB(B0, 1, 0); PG8_LDB(B1, 1, 1); PG8_SCHED; PG8_LDA(At, 1, 0); PG8_STAGE(PG8_SA(0, 1), a2, vA[1]);
            PG8_WAIT_V(8); PG8_WAIT_L(0); PG8_BAR; PG8_MMA(0, 0, At, B0); PG8_MMA(0, 1, At, B1); PG8_BAR; PG8_SCHED;
            PG8_LDA(At, 1, 1); PG8_STAGE(PG8_SB(1, 0), b3, voffB); PG8_STAGE(PG8_SB(1, 1), b3 + hstep, voffB); PG8_STAGE(PG8_SA(1, 0), a3, vA[0]);
            PG8_WAIT_V(8); PG8_WAIT_L(0); PG8_BAR; PG8_MMA(1, 0, At, B0); PG8_MMA(1, 1, At, B1); PG8_BAR; PG8_SCHED;
        }
        if (wr == 0) PG8_BAR;
        E(acc, cur, wr, wc, fr, fq);
        if (!has_next) break;
#pragma unroll
        for (int a = 0; a < 2; ++a)
#pragma unroll
            for (int b = 0; b < 2; ++b)
#pragma unroll
                for (int m = 0; m < 4; ++m)
#pragma unroll
                    for (int n = 0; n < 2; ++n) acc[a][b][m][n] = (f32x4){0.f, 0.f, 0.f, 0.f};
        cur = nxt; cB = nB; ++ui;
        if (wr == 1) PG8_BAR;
    }
    PG8_WAIT_V(0);
    PG8_BAR;
#undef PG8_SA
#undef PG8_SB
#undef PG8_STAGE
#undef PG8_LDA
#undef PG8_LDB
#undef PG8_MMA
#undef PG8_WAIT_V
#undef PG8_WAIT_L
#undef PG8_BAR
#undef PG8_SCHED
}
}

constexpr size_t RD2 = (size_t)R * D * 2;
constexpr size_t WS_CTL = 0, CTL_ZERO_BYTES = 1048576;
constexpr size_t WS_MOD = WS_CTL + CTL_ZERO_BYTES;
constexpr size_t WS_CTXB = WS_MOD + 262144;
constexpr size_t WS_TKE = WS_CTXB + (size_t)NB * CTX * D * 4;
constexpr size_t WS_TKP = WS_TKE + (size_t)R * 8 * 4, WS_TKW = WS_TKP + (size_t)R * 8 * 4;
constexpr size_t WS_LIST = WS_TKW + (size_t)R * 8 * 4;
constexpr size_t WS_LRU = WS_LIST + (size_t)NE * R * 4;
constexpr size_t WS_W_IN0 = WS_LRU + (size_t)2 * NB * NCH * D * 2 * 4;
constexpr int NIN0 = 5376;
constexpr size_t WS_W_OUT0 = WS_W_IN0 + (size_t)NIN0 * D * 2;
constexpr size_t WS_W_IN1 = WS_W_OUT0 + (size_t)D * 2 * D * 2;
constexpr size_t WS_W_OUT1 = WS_W_IN1 + (size_t)CC * D * 2;
constexpr size_t WS_W_LRU = WS_W_OUT1 + (size_t)D * D * 2;
constexpr size_t WS_W_RT = WS_W_LRU + (size_t)2 * 2 * 8 * 128 * 128 * 2;
constexpr size_t WS_W2T = WS_W_RT + (size_t)2 * 2 * NE * D * 2;
constexpr size_t WS_B = WS_W2T + (size_t)65 * D * FF * 2;
constexpr int MAXTILES = 676;
constexpr size_t AREA_B_BYTES = 89128960;
constexpr size_t WS_A = WS_B + AREA_B_BYTES;
constexpr size_t AREA_A_BYTES = (size_t)MAXTILES * 256 * D * 2;
constexpr size_t WS_DBG = WS_A + AREA_A_BYTES;
constexpr size_t WS_W1T1 = WS_DBG, WS_W2T1 = WS_W1T1 + (size_t)65 * 512 * D;
constexpr size_t WS_END_W = WS_W2T1 + (size_t)65 * D * FF;
constexpr size_t LRU_PIECE = (size_t)34 * 64 * D * 2;
constexpr size_t WS_END_PROD = MK_DEBUG ? WS_DBG : WS_END_W + 2 * LRU_PIECE;
static_assert(AREA_B_BYTES >= (size_t)MAXTILES * 256 * FF * 2 && AREA_B_BYTES >= 2 * RD2, "AREA_B");
constexpr size_t A_GX = 0, A_XL = RD2, A_Q = 2 * RD2, A_K = 2 * RD2 + RD2 / 2, A_V = 3 * RD2, A_SG = 4 * RD2, A_ALR = 5 * RD2, A_KV = 5 * RD2 + (size_t)R * 32 * 2;
constexpr size_t KV_BYTES = (size_t)32 * NCH * 32768 * 2;
static_assert(A_KV + KV_BYTES <= AREA_A_BYTES, "mixer overlay");
constexpr size_t A_DEC_ = A_KV + KV_BYTES, A_FREE = A_DEC_ + (size_t)2 * 64 * NCH * 128 * 4;
static_assert(A_FREE + 6 * LRU_PIECE <= AREA_A_BYTES && 2 * RD2 + 4 * LRU_PIECE <= AREA_B_BYTES && 3 * LRU_PIECE <= (size_t)65 * D * FF && LRU_PIECE <= (size_t)NE * R * 4, "lru pieces");
__device__ __forceinline__ size_t lru_piece(int i) {
    return i < 6 ? WS_A + A_FREE + (size_t)i * LRU_PIECE : i < 10 ? WS_B + 2 * RD2 + (size_t)(i - 6) * LRU_PIECE : i < 13 ? WS_W2T + (size_t)(i - 10) * LRU_PIECE : i < 14 ? WS_LIST : WS_END_W + (size_t)(i - 14) * LRU_PIECE;
}
constexpr size_t A_Q1 = 0, A_ZF = RD2, A_ZB = 2 * RD2, A_V1 = 3 * RD2, A_SG1 = 4 * RD2;
constexpr size_t A_W1T = 0;
constexpr size_t A_H = (size_t)65 * 512 * D * 2, A_HL = A_H + RD2, A_O = 4 * RD2;
constexpr size_t A_H8 = 5 * RD2;
static_assert(A_HL + RD2 <= A_O, "moe overlay");
constexpr size_t B_H0 = 0, B_Y = 0, B_ACT = 0, B_H1 = 0, B_Y1 = RD2;
constexpr int CW_TMO = 0, CW_CODE = 1, CW_BAR = 4096, CW_CNT = 8192  , CW_DBG = 16384;

constexpr int RING_BYTES = 131072;
constexpr int MISC_OFF = 157696;
constexpr int LDS_BYTES = 157696 + 128;
constexpr int NWAVES = 8;

typedef GAS unsigned gu32;
#define RLX_AGENT __ATOMIC_RELAXED, __HIP_MEMORY_SCOPE_AGENT

#define XB_TMO      128
#define XB_XCNT(j)  (256  + 64 * (j))
#define XB_XSUB(j)  (1280 + 64 * (j))
#define XB_XGEN(j)  (2304 + 64 * (j))
#define XB_TOP      3328
#define XB_TOPGEN   3392
#define XCD_BAR_WORDS 3456
#define XB_SPIN_CAP (1u << 20)
__device__ __forceinline__ unsigned xb_ld(unsigned* p)              { return __hip_atomic_load(p, __ATOMIC_RELAXED, __HIP_MEMORY_SCOPE_AGENT); }
__device__ __forceinline__ unsigned xb_add(unsigned* p, unsigned v) { return __hip_atomic_fetch_add(p, v, __ATOMIC_RELAXED, __HIP_MEMORY_SCOPE_AGENT); }
__device__ __forceinline__ unsigned xb_xcc_id() { return (unsigned)__builtin_amdgcn_s_getreg((3 << 11) | 20) & 0xFu; }
#define XB_SPIN(cond, bar) do { unsigned _sp = 0; while (cond) { __builtin_amdgcn_s_sleep(1); \
    if ((++_sp & 255u) == 0u) { if (xb_ld(&(bar)[XB_TMO])) break; if (_sp > XB_SPIN_CAP) { atomicAdd(&(bar)[XB_TMO], 1u); break; } } } } while (0)
struct XcdBarrier { unsigned* bar; unsigned x; volatile LAS unsigned* st; };
__device__ __forceinline__ XcdBarrier xcd_barrier_post(unsigned* bar, volatile LAS unsigned* st) {
    XcdBarrier b; b.bar = bar; b.x = xb_xcc_id(); b.st = st;
    if (threadIdx.x == 0) (void)xb_add(&bar[XB_XCNT(b.x)], 1u);
    return b;
}
__device__ __forceinline__ void xcd_barrier_complete(unsigned* bar, unsigned x, unsigned& nloc, unsigned& nx) {
    const unsigned G = gridDim.x * gridDim.y * gridDim.z;
    unsigned sum, cnt, mine, sp = 0u;
    for (;;) {
        sum = 0u; cnt = 0u; mine = 0u;
#pragma unroll
        for (unsigned j = 0; j < 16; ++j) { const unsigned c = xb_ld(&bar[XB_XCNT(j)]); sum += c; cnt += (c > 0u) ? 1u : 0u; mine = (j == x) ? c : mine; }
        if (sum == G) break;
        __builtin_amdgcn_s_sleep(1);
        if ((++sp & 255u) == 0u) { if (xb_ld(&bar[XB_TMO])) break; if (sp > XB_SPIN_CAP) { atomicAdd(&bar[XB_TMO], 1u); break; } }
    }
    nloc = mine > 0u ? mine : 1u; nx = cnt > 0u ? cnt : 1u;
}
__device__ __forceinline__ void xcd_barrier(const XcdBarrier& b) {
    asm volatile("s_waitcnt vmcnt(0)" ::: "memory");
    __syncthreads();
    if (threadIdx.x == 0) {
        unsigned* bar = b.bar;
        __builtin_amdgcn_s_waitcnt(0);
        unsigned nloc = b.st[0], nx = b.st[1];
        if (nloc == 0u) { xcd_barrier_complete(bar, b.x, nloc, nx); b.st[0] = nloc; b.st[1] = nx; }
        const unsigned old = xb_add(&bar[XB_XSUB(b.x)], 1u);
        const unsigned gen = old / nloc;
        if (old + 1u == (gen + 1u) * nloc) {
            __builtin_amdgcn_fence(__ATOMIC_RELEASE, "agent");
            asm volatile("s_waitcnt vmcnt(0)" ::: "memory");
            const unsigned og = xb_add(&bar[XB_TOP], 1u);
            const unsigned tg = og / nx;
            if (og + 1u == (tg + 1u) * nx) xb_add(&bar[XB_TOPGEN], 1u);
            else XB_SPIN(xb_ld(&bar[XB_TOPGEN]) == tg, bar);
            __builtin_amdgcn_fence(__ATOMIC_ACQUIRE, "agent");
            xb_add(&bar[XB_XGEN(b.x)], 1u);
            asm volatile("s_waitcnt vmcnt(0)" ::: "memory");
        } else {
            XB_SPIN(xb_ld(&bar[XB_XGEN(b.x)]) == gen, bar);
            __builtin_amdgcn_fence(__ATOMIC_ACQUIRE, "agent");
            asm volatile("s_waitcnt vmcnt(0)" ::: "memory");
        }
    }
    __syncthreads();
}

struct Args { const float* in[30]; float* out; unsigned char* ws; int ph_lo, ph_hi, abl, pad; };
struct Frame {
    LAS unsigned char* lds;
    volatile LAS unsigned* MISC;
    gu32* ctl;
    int tid, lane, wave, vcu, G;
    unsigned char* ws;
    float* out;
};
enum { I_X = 0, I_C, I_CTX, I_CCTX, I_MODW, I_MODB, I_PREG, I_POSTG, I_ABWIN, I_CONVW, I_CONVB, I_LRUWA, I_LRUBA, I_LRUWI, I_LRUBI, I_LRULAM, I_GLAWA2, I_GLABA, I_ABWOUT,
       I_CWIN, I_LBL, I_CWOUT, I_ROUTER, I_MOEB, I_WG, I_WU, I_WD, I_WSG, I_WSU, I_WSD };

__device__ __forceinline__ int mod_row(int row) { const int b = row / T, s = row - b * T; return s < CTX ? 4 : b; }

__device__ __forceinline__ void transpose_item(const float* Wsrc, int ldw, bf16* WTdst, int ldt, int rs, LAS float* scr, int lane) {
    float wv[32];
#pragma unroll
    for (int i = 0; i < 32; ++i) { const int kk = 2 * i + (lane >> 5); wv[i] = __builtin_nontemporal_load(Wsrc + (size_t)kk * ldw + (lane & 31)); }
#pragma unroll
    for (int i = 0; i < 32; ++i) { const int kk = 2 * i + (lane >> 5); scr[kk * 33 + (lane & 31)] = wv[i]; }
    LDS_WAIT(); asm volatile("" ::: "memory");
    const int c = lane & 7;
#pragma unroll
    for (int j = 0; j < 4; ++j) { const int n = (lane >> 3) + 8 * j; const LAS float* s = scr + (8 * c) * 33 + n;
        v4u o; o.x = hwpk2(s[0 * 33], s[1 * 33]); o.y = hwpk2(s[2 * 33], s[3 * 33]); o.z = hwpk2(s[4 * 33], s[5 * 33]); o.w = hwpk2(s[6 * 33], s[7 * 33]);
        if (rs) *(GAS v4u*)(WTdst + (size_t)((n >> 2) * rs + (n & 3)) * ldt + 8 * c) = o;
        else *(GAS v4u*)(WTdst + (size_t)((((c >> 1) * 2 + (c & 1)) * 32 + n) * 8)) = o; }
    LDS_WAIT(); asm volatile("" ::: "memory");
}
__device__ __forceinline__ void transpose_item8(const float* Wsrc, int ldw, unsigned char* WTdst, int ldt, int rs, LAS float* scr, int lane) {
    float wv[32];
#pragma unroll
    for (int i = 0; i < 32; ++i) { const int kk = 2 * i + (lane >> 5); wv[i] = __builtin_nontemporal_load(Wsrc + (size_t)kk * ldw + (lane & 31)); }
#pragma unroll
    for (int i = 0; i < 32; ++i) { const int kk = 2 * i + (lane >> 5); scr[kk * 33 + (lane & 31)] = wv[i] * 64.f; }
    LDS_WAIT(); asm volatile("" ::: "memory");
    const int c = lane & 7;
#pragma unroll
    for (int j = 0; j < 4; ++j) { const int n = (lane >> 3) + 8 * j; const LAS float* s = scr + (8 * c) * 33 + n;
        v2u o; o.x = pk4f8(s[0 * 33], s[1 * 33], s[2 * 33], s[3 * 33]); o.y = pk4f8(s[4 * 33], s[5 * 33], s[6 * 33], s[7 * 33]);
        *(GAS v2u*)(WTdst + (size_t)((n >> 2) * rs + (n & 3)) * ldt + 8 * c) = o; }
    LDS_WAIT(); asm volatile("" ::: "memory");
}
__device__ __forceinline__ void transpose_matrix8(const float* W, int K, int N, int ldw, unsigned char* WT, int ldt, int rs, LAS float* scr, int lane, int gw, int NGW, int& itbase) {
    const int nblk = N / 32, nitems = (K / 64) * nblk;
    int first = (gw - itbase % NGW + NGW) % NGW;
    for (int it = first; it < nitems; it += NGW) { const int kb = it / nblk, nb = it % nblk;
        transpose_item8(W + (size_t)(64 * kb) * ldw + 32 * nb, ldw, WT + (size_t)(32 * nb / 4 * rs) * ldt + 64 * kb, ldt, rs, scr, lane); }
    itbase += nitems;
}
__device__ __forceinline__ void transpose_matrix(const float* W, int K, int N, int ldw, bf16* WT, int ldt, int rs, LAS float* scr, int lane, int gw, int NGW, int& itbase) {
    const int nblk = N / 32, nitems = (K / 64) * nblk;
    int first = (gw - itbase % NGW + NGW) % NGW;
    for (int it = first; it < nitems; it += NGW) { const int kb = it / nblk, nb = it % nblk;
        if (rs) transpose_item(W + (size_t)(64 * kb) * ldw + 32 * nb, ldw, WT + (size_t)(32 * nb / 4 * rs) * ldt + 64 * kb, ldt, rs, scr, lane);
        else transpose_item(W + (size_t)(64 * kb) * ldw + 32 * nb, ldw, WT + ((size_t)nb * (K / 16) + 4 * kb) * 512, ldt, 0, scr, lane); }
    itbase += nitems;
}

__device__ __forceinline__ void p0_prep(Frame& F, const Args& A) {
    if (F.vcu < 192) {
        LAS float* sv = (LAS float*)F.lds;
        LAS float* red = (LAS float*)(F.lds + 20480);
        for (int i = F.tid; i < 5 * D; i += NWAVES * 64) { const int r = i >> 10, k = i & 1023; const float t = r < 4 ? A.in[I_C][r * D + k] : A.in[I_CCTX][k]; sv[i] = t / (1.f + expf(-t)); }
        __syncthreads();
        const int l = F.vcu / 96, n0 = (F.vcu % 96) * 64;
        const float* W = A.in[I_MODW] + (size_t)l * D * NMOD + n0 + F.lane;
        float acc[5] = {0.f, 0.f, 0.f, 0.f, 0.f};
        const int k0 = F.wave * 128;
#pragma unroll 1
        for (int kk = 0; kk < 128; kk += 32) {
            float w[32];
#pragma unroll
            for (int j = 0; j < 32; ++j) w[j] = __builtin_nontemporal_load(W + (size_t)(k0 + kk + j) * NMOD);
#pragma unroll
            for (int j = 0; j < 32; ++j)
#pragma unroll
                for (int r = 0; r < 5; ++r) acc[r] += sv[r * D + k0 + kk + j] * w[j];
        }
#pragma unroll
        for (int r = 0; r < 5; ++r) red[(F.wave * 5 + r) * 64 + F.lane] = acc[r];
        __syncthreads();
        if (F.tid < 320) { const int r = F.tid >> 6, ln = F.tid & 63; float s = 0.f;
#pragma unroll
            for (int w = 0; w < 8; ++w) s += red[(w * 5 + r) * 64 + ln];
            ((float*)(F.ws + WS_MOD))[(size_t)(l * 5 + r) * NMOD + n0 + ln] = s + A.in[I_MODB][l * NMOD + n0 + ln]; }
        __syncthreads();
    }
    LAS float* scr = (LAS float*)(F.lds + F.wave * 16384);
    const int gw = F.vcu * NWAVES + F.wave, NGW = F.G * NWAVES;
    int itb = 0;
    transpose_matrix(A.in[I_ABWIN], D, ABC, ABC, (bf16*)(F.ws + WS_W_IN0), D, 4, scr, F.lane, gw, NGW, itb);
    transpose_matrix(A.in[I_ABWOUT], 2 * D, D, D, (bf16*)(F.ws + WS_W_OUT0), 2 * D, 4, scr, F.lane, gw, NGW, itb);
    transpose_matrix(A.in[I_CWIN], D, CC, CC, (bf16*)(F.ws + WS_W_IN1), D, 4, scr, F.lane, gw, NGW, itb);
    transpose_matrix(A.in[I_CWOUT], D, D, D, (bf16*)(F.ws + WS_W_OUT1), D, 4, scr, F.lane, gw, NGW, itb);
    for (int mtx = 0; mtx < 32; ++mtx) {
        const int d = mtx >> 4, ai = (mtx >> 3) & 1, h = mtx & 7;
        transpose_matrix(A.in[ai ? I_LRUWI : I_LRUWA] + (size_t)(d * 8 + h) * 16384, 128, 128, 128, (bf16*)(F.ws + WS_W_LRU) + (size_t)mtx * 16384, 128, 0, scr, F.lane, gw, NGW, itb);
    }
    for (int i = F.vcu * NWAVES * 64 + F.tid; i < D; i += F.G * NWAVES * 64) { const float l0 = A.in[I_LBL][i], l1 = A.in[I_LBL][D + i]; ((float*)(F.ws + WS_MOD + 245760))[i] = 1.f / (1.f + expf(l0 - l1)); }
    const int gt = F.vcu * NWAVES * 64 + F.tid, NGT = F.G * NWAVES * 64;
    for (int i = gt; i < 224 * D / 8; i += NGT) ((GAS v4u*)(F.ws + WS_W_IN0 + (size_t)ABC * D * 2))[i] = (v4u){0u, 0u, 0u, 0u};
    for (int i = gt; i < 2 * NE * D; i += NGT) { const int l = i / (NE * D), e = (i / D) % NE, k = i % D;
        const float w = A.in[I_ROUTER][((size_t)l * D + k) * NE + e]; const unsigned hi = f2bf(w); const float lo = w - bf2f(hi);
        bf16* rt = (bf16*)(F.ws + WS_W_RT) + (size_t)l * 2 * NE * D;
        const size_t o = ((size_t)((e >> 4) * 32 + (k >> 5)) * 64 + ((k >> 3) & 3) * 16 + (e & 15)) * 8 + (k & 7);
        rt[o] = (bf16)hi; rt[(size_t)NE * D + o] = (bf16)f2bf(lo); }
}

template <int CTRL, int ROWMASK> __device__ __forceinline__ float dpp_add(float v) { return v + __builtin_bit_cast(float, __builtin_amdgcn_update_dpp(0, __builtin_bit_cast(int, v), CTRL, ROWMASK, 0xf, false)); }
__device__ __forceinline__ float row_sum16(float v) { v = dpp_add<0xB1, 0xf>(v); v = dpp_add<0x4E, 0xf>(v); v = dpp_add<0x141, 0xf>(v); v = dpp_add<0x140, 0xf>(v); return v; }
__device__ __forceinline__ float wsum(float v) {
    v = row_sum16(v);
    v = dpp_add<0x142, 0xa>(v);
    v = dpp_add<0x143, 0xc>(v);
    return __builtin_bit_cast(float, __builtin_amdgcn_readlane(__builtin_bit_cast(int, v), 63));
}
__device__ __forceinline__ void row_load_f32(const float* p, int lane, f32x4 (&v)[4]) {
#pragma unroll
    for (int j = 0; j < 4; ++j) v[j] = ((const GAS f32x4*)p)[lane + 64 * j];
}
__device__ __forceinline__ void row_load_bf16(const bf16* p, int lane, f32x4 (&v)[4]) {
#pragma unroll
    for (int j = 0; j < 4; ++j) { const v2u w = ((const GAS v2u*)p)[lane + 64 * j]; v[j] = (f32x4){bflo(w.x), bfhi(w.x), bflo(w.y), bfhi(w.y)}; }
}
__device__ __forceinline__ void row_load_f8(const unsigned char* p, int lane, f32x4 (&v)[4]) {
#pragma unroll
    for (int j = 0; j < 4; ++j) { const int w = (int)((const GAS unsigned*)p)[lane + 64 * j]; const f32x2 lo = __builtin_amdgcn_cvt_pk_f32_fp8(w, false), hi = __builtin_amdgcn_cvt_pk_f32_fp8(w, true); v[j] = (f32x4){lo.x, lo.y, hi.x, hi.y}; }
}
__device__ __forceinline__ float row_ss(const f32x4 (&v)[4]) {
    float s = 0.f;
#pragma unroll
    for (int j = 0; j < 4; ++j) s += (v[j].x * v[j].x + v[j].y * v[j].y) + (v[j].z * v[j].z + v[j].w * v[j].w);
    return wsum(s);
}
__device__ __forceinline__ void row_store_bf16(bf16* p, int lane, const f32x4 (&v)[4]) {
#pragma unroll
    for (int j = 0; j < 4; ++j) { v2u w; w.x = hwpk2(v[j].x, v[j].y); w.y = hwpk2(v[j].z, v[j].w); ((GAS v2u*)p)[lane + 64 * j] = w; }
}
__device__ __forceinline__ void row_prenorm(const f32x4 (&x)[4], float rstd, const float* gain, const float* mscale, const float* mshift, int lane, f32x4 (&h)[4]) {
#pragma unroll
    for (int j = 0; j < 4; ++j) { const f32x4 g = ((const GAS f32x4*)gain)[lane + 64 * j], sc = ((const GAS f32x4*)mscale)[lane + 64 * j], sh = ((const GAS f32x4*)mshift)[lane + 64 * j];
        h[j] = x[j] * rstd * g * (sc + 1.0f) + sh; }
}

__device__ __forceinline__ void p1_prenorm0(Frame& F, const Args& A) {
    const int gw = F.vcu * NWAVES + F.wave, NGW = F.G * NWAVES;
    const float* Ml = (const float*)(F.ws + WS_MOD);
    bf16* H0 = (bf16*)(F.ws + WS_B + B_H0);
    for (int row = gw; row < R; row += NGW) {
        const float* m = Ml + (size_t)mod_row(row) * NMOD;
        f32x4 x[4], h[4];
        row_load_f32(row_src(A.in[I_X], A.in[I_CTX], row), F.lane, x);
        const float rstd = rsqrtf(row_ss(x) * (1.f / D) + EPS);
        row_prenorm(x, rstd, A.in[I_PREG], m + 1 * D, m + 0 * D, F.lane, h);
        row_store_bf16(H0 + (size_t)row * D, F.lane, h);
    }
}

struct SchedPlain {
    const bf16* Ap; const bf16* Bt; int K, nM, nN, G, c, lat_only;
    __device__ __forceinline__ bool next(int i, pg8::Unit& u) const {
        const int nwg = nM * nN; const long L = (long)i * G + c; if (L >= nwg) return false;
        const int wgid = pg8::xcd_remap((int)L, nwg);
        const int nig = pg8::WGM * nN, gid = wgid / nig, fm = gid * pg8::WGM, gsz = (nM - fm) < pg8::WGM ? (nM - fm) : pg8::WGM;
        u.pm = fm + ((wgid % nig) % gsz); u.pn = (wgid % nig) / gsz; u.e = 0;
        u.arow0 = lat_only ? ((u.pm >> 4) * T + CTX + (u.pm & 15) * 256) : u.pm * 256;
        return true;
    }
    __device__ __forceinline__ void a_offs(const pg8::Unit& u, unsigned (&v)[2][2], int tid) const {
#pragma unroll
        for (int i = 0; i < 2; ++i) { int R_, C_; pg8::stage_rc(tid * 16 + i * 8192, R_, C_);
            v[0][i] = (unsigned)((u.arow0 + R_) * K + C_) * 2u; v[1][i] = (unsigned)((u.arow0 + pg8::HALF + R_) * K + C_) * 2u; }
    }
    __device__ __forceinline__ const char* a_base() const { return (const char*)Ap; }
    __device__ __forceinline__ const char* b_base(const pg8::Unit& u) const { return (const char*)Bt + (size_t)u.pn * 256 * K * 2; }
};

template <int ACT, bool F16>
__device__ __forceinline__ void store_tile16(const f32x4 (&acc)[2][2][4][2], unsigned short* dst, int ld, int row0, int wr, int wc, int fr, int fq, float scale) {
#pragma unroll
    for (int ai = 0; ai < 2; ++ai)
#pragma unroll
        for (int m = 0; m < 4; ++m) { unsigned short* rowp = dst + (size_t)(row0 + ai * 128 + wr * 64 + m * 16 + fr) * ld + wc * 32 + 8 * fq;
#pragma unroll
            for (int bj = 0; bj < 2; ++bj) { f32x4 v0 = acc[ai][bj][m][0], v1 = acc[ai][bj][m][1];
                if (ACT == 1) {
#pragma unroll
                    for (int j = 0; j < 4; ++j) { v0[j] = fgelu(v0[j]); v1[j] = fgelu(v1[j]); } }
                if (ACT == 2) {
#pragma unroll
                    for (int j = 0; j < 4; ++j) { v0[j] = fsilu(v0[j]); v1[j] = fsilu(v1[j]); } }
                if (ACT == 3) { v0 = v0 * scale; v1 = v1 * scale; }
                v4u w;
                if (F16) { w.x = pk2h(v0[0], v0[1]); w.y = pk2h(v0[2], v0[3]); w.z = pk2h(v1[0], v1[1]); w.w = pk2h(v1[2], v1[3]); }
                else { w.x = cvt_pk_bf16(v0[0], v0[1]); w.y = cvt_pk_bf16(v0[2], v0[3]); w.z = cvt_pk_bf16(v1[0], v1[1]); w.w = cvt_pk_bf16(v1[2], v1[3]); }
                *(GAS v4u*)(rowp + bj * 128) = w; } }
}
struct EpiIn0 {
    unsigned char* a;
    __device__ __forceinline__ bool full(const pg8::Unit& u) const { return u.pn < 20; }
    __device__ __forceinline__ void operator()(const f32x4 (&acc)[2][2][4][2], const pg8::Unit& u, int wr, int wc, int fr, int fq) const {
        const int pn = u.pn, r0 = u.arow0;
        if (pn < 4) store_tile16<1, false>(acc, (bf16*)(a + A_GX) + pn * 256, D, r0, wr, wc, fr, fq, 1.f);
        else if (pn < 8) store_tile16<0, false>(acc, (bf16*)(a + A_XL) + (pn - 4) * 256, D, r0, wr, wc, fr, fq, 1.f);
        else if (pn < 10) store_tile16<3, false>(acc, (bf16*)(a + A_Q) + (pn - 8) * 256, 512, r0, wr, wc, fr, fq, 0.08838834764831845f);
        else if (pn < 12) store_tile16<0, false>(acc, (bf16*)(a + A_K) + (pn - 10) * 256, 512, r0, wr, wc, fr, fq, 1.f);
        else if (pn < 16) store_tile16<0, false>(acc, (bf16*)(a + A_V) + (pn - 12) * 256, D, r0, wr, wc, fr, fq, 1.f);
        else if (pn < 20) store_tile16<2, false>(acc, (bf16*)(a + A_SG) + (pn - 16) * 256, D, r0, wr, wc, fr, fq, 1.f);
        else if (wc == 0) {
            f16b* dst = (f16b*)(a + A_ALR);
#pragma unroll
            for (int ai = 0; ai < 2; ++ai)
#pragma unroll
                for (int m = 0; m < 4; ++m) { const f32x4 v0 = acc[ai][0][m][0], v1 = acc[ai][0][m][1];
                    v4u w; w.x = pk2h(v0[0], v0[1]); w.y = pk2h(v0[2], v0[3]); w.z = pk2h(v1[0], v1[1]); w.w = pk2h(v1[2], v1[3]);
                    *(GAS v4u*)(dst + (size_t)(r0 + ai * 128 + wr * 64 + m * 16 + fr) * 32 + 8 * fq) = w; }
        }
    }
};

__device__ __forceinline__ void p2_tail(Frame& F, const Args& A);
__device__ __forceinline__ void p2_inproj0(Frame& F, const Args& A) {
    SchedPlain S{(const bf16*)(F.ws + WS_B + B_H0), (const bf16*)(F.ws + WS_W_IN0), D, R / 256, NIN0 / 256, F.G, (int)blockIdx.x, 0};
    EpiIn0 E{F.ws + WS_A};
    pg8::gemm_phase<EpiIn0, SchedPlain>(F.lds, D, S, E);
    p2_tail(F, A);
}

__device__ __forceinline__ unsigned off_b(unsigned row, unsigned ch) { return 256u * row + 16u * (ch ^ (((row & 3u) << 2) | ((row >> 2) & 3u))); }
__device__ __forceinline__ bf16x8 row_frag(const LAS unsigned char* img, unsigned row0, unsigned lane, unsigned s) { return *(const LAS bf16x8*)(img + off_b(row0 + (lane & 31u), 2u * s + (lane >> 5))); }
__device__ __forceinline__ unsigned tr_addr(unsigned lane, unsigned c, unsigned t) {
    const unsigned h = lane >> 5, blk = (lane >> 4) & 1u, q = (lane & 15u) >> 2, p = lane & 3u;
    return off_b(8u * h + 4u * t + q, 4u * c + 2u * blk + (p >> 1)) + 8u * (p & 1u);
}
__device__ __forceinline__ void tr_read_k64(unsigned a0, unsigned a1, bf16x8 (&f)[4]) {
    v2u r00, r01, r10, r11, r20, r21, r30, r31;
    asm volatile("ds_read_b64_tr_b16 %0, %8\n\tds_read_b64_tr_b16 %1, %9\n\tds_read_b64_tr_b16 %2, %8 offset:4096\n\tds_read_b64_tr_b16 %3, %9 offset:4096\n\t"
                 "ds_read_b64_tr_b16 %4, %8 offset:8192\n\tds_read_b64_tr_b16 %5, %9 offset:8192\n\tds_read_b64_tr_b16 %6, %8 offset:12288\n\tds_read_b64_tr_b16 %7, %9 offset:12288\n\ts_waitcnt lgkmcnt(0)"
                 : "=&v"(r00), "=&v"(r01), "=&v"(r10), "=&v"(r11), "=&v"(r20), "=&v"(r21), "=&v"(r30), "=&v"(r31) : "v"(a0), "v"(a1) : "memory");
    f[0] = __builtin_bit_cast(bf16x8, (v4u){r00.x, r00.y, r01.x, r01.y}); f[1] = __builtin_bit_cast(bf16x8, (v4u){r10.x, r10.y, r11.x, r11.y});
    f[2] = __builtin_bit_cast(bf16x8, (v4u){r20.x, r20.y, r21.x, r21.y}); f[3] = __builtin_bit_cast(bf16x8, (v4u){r30.x, r30.y, r31.x, r31.y});
}
__device__ __forceinline__ unsigned lds_addr(const LAS unsigned char* p) { return (unsigned)(unsigned long)p; }
#define MFMA32(a, b, c) __builtin_amdgcn_mfma_f32_32x32x16_bf16((a), (b), (c), 0, 0, 0)
__device__ __forceinline__ float flogsigm(float z) { return fminf(z, 0.f) - 0.6931471805599453f * __builtin_amdgcn_logf(1.f + fexp(-fabsf(z))); }
__device__ __forceinline__ f32x16 zero16() { f32x16 z; for (int i = 0; i < 16; ++i) z[i] = 0.f; return z; }
__device__ __forceinline__ int chunk_scan_index(int c, int dir) { return dir ? (c < 4 ? 3 - c : 71 - c) : c; }

struct ChunkP {
    const bf16* q; int ldq;
    const bf16* k; int ldk;
    const bf16* v; int ldv;
    const f16b* alr;
    const float* wa2; const float* gba;
    const f16b* z[2];
    const float* lbl;
    const bf16* sg; bf16* y; int ldy, ycol0;
    bf16* kv; float* dec;
};

__device__ __forceinline__ void unpack8(const v4u w, float (&f)[8]) { f[0] = bflo(w.x); f[1] = bfhi(w.x); f[2] = bflo(w.y); f[3] = bfhi(w.y); f[4] = bflo(w.z); f[5] = bfhi(w.z); f[6] = bflo(w.w); f[7] = bfhi(w.w); }
template <int DV>
__device__ __forceinline__ void load_v_tile(const Frame& F, const bf16* v, int ldv, size_t row0, int col0, LAS unsigned char* Vimg) {
    constexpr int CPR = DV / 8;
    constexpr int NT_ = 64 * CPR / (NWAVES * 64);
    v4u w[NT_];
#pragma unroll
    for (int t = 0; t < NT_; ++t) { const int i = F.tid + t * NWAVES * 64, m = i / CPR, chx = i % CPR; w[t] = *(const GAS v4u*)(v + (row0 + m) * ldv + col0 + chx * 8); }
#pragma unroll
    for (int t = 0; t < NT_; ++t) { const int i = F.tid + t * NWAVES * 64, m = i / CPR, chx = i % CPR; *(LAS v4u*)(Vimg + (chx >> 4) * 16384 + off_b(m, chx & 15)) = w[t]; }
}
__device__ __forceinline__ void load_alr_tile(const Frame& F, const f16b* alr, size_t row0, LAS float* alr_s) {
    int t_ = F.tid; asm volatile("" : "+v"(t_));
    const v2u w = *(const GAS v2u*)(alr + row0 * 32 + t_ * 4);
    *(LAS f32x4*)(alr_s + t_ * 4) = (f32x4){h2f((unsigned short)(w.x & 0xffffu)), h2f((unsigned short)(w.x >> 16)), h2f((unsigned short)(w.y & 0xffffu)), h2f((unsigned short)(w.y >> 16))};
}
__device__ __forceinline__ void stage_raw_tile(const Frame& F, const unsigned short* src, int ld, size_t row0, int col0, LAS unsigned char* dst) {
    v4u w[2];
#pragma unroll
    for (int t = 0; t < 2; ++t) { const int i = F.tid + t * NWAVES * 64, m = i >> 4, ch = i & 15; w[t] = *(const GAS v4u*)(src + (row0 + m) * ld + col0 + ch * 8); }
#pragma unroll
    for (int t = 0; t < 2; ++t) { const int i = F.tid + t * NWAVES * 64, m = i >> 4, ch = i & 15; *(LAS v4u*)(dst + m * 272 + ch * 16) = w[t]; }
}
struct SegIn { unsigned q[8]; unsigned kz[8]; float w[16]; float bias; };
template <bool HG, bool WITHQ>
__device__ __forceinline__ void seg_load(const ChunkP& P, const LAS unsigned char* rawq, const LAS unsigned char* rawk, int h, int d, int seg, int dir, SegIn& S) {
#pragma unroll
    for (int i = 0; i < 16; i += 2) { const int p = seg * 16 + i, m0 = dir ? 63 - p : p, m1 = dir ? m0 - 1 : m0 + 1;
        if (WITHQ) S.q[i >> 1] = (unsigned)*(const LAS unsigned short*)(rawq + m0 * 272 + d * 2) | ((unsigned)*(const LAS unsigned short*)(rawq + m1 * 272 + d * 2) << 16);
        S.kz[i >> 1] = (unsigned)*(const LAS unsigned short*)(rawk + m0 * 272 + d * 2) | ((unsigned)*(const LAS unsigned short*)(rawk + m1 * 272 + d * 2) << 16); }
    if (!HG) {
#pragma unroll
        for (int r = 0; r < 16; ++r) S.w[r] = P.wa2[((size_t)dir * 16 + r) * 512 + h * 128 + d];
        S.bias = P.gba[dir * 512 + h * 128 + d];
    }
}
template <bool HG>
__device__ __forceinline__ void seg_load_g(const ChunkP& P, size_t row0, int h, int d, int seg, int dir, SegIn& S) {
    const unsigned short* kp = HG ? (const unsigned short*)((dir ? P.z[1] : P.z[0]) + row0 * D + h * 128 + d) : (const unsigned short*)(P.k + row0 * P.ldk + h * 128 + d);
    const int ldk = HG ? D : P.ldk;
#pragma unroll
    for (int i = 0; i < 16; i += 2) { const int p = seg * 16 + i, m0 = dir ? 63 - p : p, m1 = dir ? m0 - 1 : m0 + 1;
        S.kz[i >> 1] = (unsigned)((const GAS unsigned short*)kp)[(size_t)m0 * ldk] | ((unsigned)((const GAS unsigned short*)kp)[(size_t)m1 * ldk] << 16); }
    if (!HG) {
#pragma unroll
        for (int r = 0; r < 16; ++r) S.w[r] = P.wa2[((size_t)dir * 16 + r) * 512 + h * 128 + d];
        S.bias = P.gba[dir * 512 + h * 128 + d];
    }
}
template <bool HG>
__device__ __forceinline__ float seg_gates(const SegIn& S, float lb, int seg, int dir, const LAS float* alr_s, float (&g)[16], float (&kf)[16]) {
#pragma unroll
    for (int i = 0; i < 16; ++i) {
        const unsigned short kzi = (unsigned short)((i & 1) ? (S.kz[i >> 1] >> 16) : (S.kz[i >> 1] & 0xffffu));
        if (HG) { const float sg_ = fsigm(h2f(kzi)); g[i] = 0.6931471805599453f * __builtin_amdgcn_logf(lb + (1.f - lb) * sg_); kf[i] = (1.f - lb) * (1.f - sg_); }
        else { const int p = seg * 16 + i, m = dir ? 63 - p : p; float zz = S.bias;
#pragma unroll
            for (int r = 0; r < 16; ++r) zz += alr_s[m * 32 + dir * 16 + r] * S.w[r];
            g[i] = flogsigm(zz) * (1.f / 16.f); kf[i] = bf2f(kzi); }
    }
    float run = 0.f;
#pragma unroll
    for (int i = 0; i < 16; ++i) { run += g[i]; g[i] = run; }
    return run;
}
__device__ __forceinline__ unsigned tr_addr2(unsigned lane, unsigned c, unsigned t) {
    const unsigned h = lane >> 5, blk = (lane >> 4) & 1u, q = (lane & 15u) >> 2, p = lane & 3u;
    return off_b(8u * t + 4u * h + q, 4u * c + 2u * blk + (p >> 1)) + 8u * (p & 1u);
}
__device__ __forceinline__ void tr_read_perm32(unsigned a0, unsigned a1, bf16x8 (&f)[2]) {
    v2u r00, r01, r10, r11;
    asm volatile("ds_read_b64_tr_b16 %0, %4\n\tds_read_b64_tr_b16 %1, %5\n\tds_read_b64_tr_b16 %2, %4 offset:4096\n\tds_read_b64_tr_b16 %3, %5 offset:4096\n\ts_waitcnt lgkmcnt(0)"
                 : "=&v"(r00), "=&v"(r01), "=&v"(r10), "=&v"(r11) : "v"(a0), "v"(a1) : "memory");
    f[0] = __builtin_bit_cast(bf16x8, (v4u){r00.x, r00.y, r01.x, r01.y}); f[1] = __builtin_bit_cast(bf16x8, (v4u){r10.x, r10.y, r11.x, r11.y});
}
__device__ __forceinline__ void st16(LAS unsigned char* img, int m, int d, float v) { *(LAS unsigned short*)(img + off_b(m, d >> 3) + (d & 7) * 2) = hwbf(v); }

template <int DV, bool HG>
__device__ __forceinline__ void chunk_pass1(const Frame& F, const ChunkP& P, int NH, int v0) {
    LAS unsigned char* Kd = F.lds;
    LAS unsigned char* Vimg = F.lds + 16384;
    LAS unsigned char* Ost = F.lds + 49152;
    LAS float* segtot = (LAS float*)(F.lds + 118784);
    LAS float* alr_s = (LAS float*)(F.lds + 120832);
    LAS unsigned char* rawk = F.lds + 129024;
    const int nitems = NB * NH * 2 * NCH;
    const int d = F.tid & 127, seg = F.tid >> 7;
    for (int item = v0; item < nitems; item += F.G) {
        const int c = item % NCH, dir = (item / NCH) & 1, h = (item / (2 * NCH)) % NH, b = item / (2 * NCH * NH);
        const size_t row0 = (size_t)b * T + (size_t)c * 64;
        const float lb = HG ? P.lbl[h * 128 + d] : 0.f;
        SegIn S;
        if (HG) seg_load_g<HG>(P, row0, h, d, seg, dir, S);
        else { stage_raw_tile(F, (const unsigned short*)P.k, P.ldk, row0, h * 128, rawk); load_alr_tile(F, P.alr, row0, alr_s); }
        load_v_tile<DV>(F, P.v, P.ldv, row0, h * DV, Vimg);
        if (!HG) { __syncthreads(); seg_load<HG, false>(P, rawk, rawk, h, d, seg, dir, S); }
        float g[16], kf[16];
        segtot[seg * 128 + d] = seg_gates<HG>(S, lb, seg, dir, alr_s, g, kf);
        __syncthreads();
        float offs = 0.f, blast = 0.f;
#pragma unroll
        for (int s2 = 0; s2 < 4; ++s2) { const float t_ = segtot[s2 * 128 + d]; blast += t_; offs += (s2 < seg) ? t_ : 0.f; }
#pragma unroll
        for (int i = 0; i < 16; ++i) { const int p = seg * 16 + i, m = dir ? 63 - p : p; st16(Kd, m, d, kf[i] * fexp(blast - (g[i] + offs))); }
        const int stream = (b * NH + h) * 2 + dir, cs = chunk_scan_index(c, dir);
        if (seg == 0) P.dec[((size_t)stream * NCH + cs) * 128 + d] = fexp(blast);
        __syncthreads();
        const int et = (DV == 256) ? F.wave : (F.wave >> 1), dt0 = (DV == 256) ? 0 : 2 * (F.wave & 1);
        constexpr int NDT = (DV == 256) ? 4 : 2;
        bf16* kvp = P.kv + ((size_t)stream * NCH + cs) * (DV * 128);
        bf16x8 af[4];
        { const unsigned base = lds_addr(Vimg + (et >> 2) * 16384); tr_read_k64(base + tr_addr(F.lane, et & 3, 0), base + tr_addr(F.lane, et & 3, 1), af); }
#pragma unroll
        for (int t = 0; t < NDT; ++t) { const int dt = dt0 + t;
            bf16x8 bfr[4];
            { const unsigned base = lds_addr(Kd); tr_read_k64(base + tr_addr(F.lane, dt, 0), base + tr_addr(F.lane, dt, 1), bfr); }
            f32x16 acc = zero16();
#pragma unroll
            for (int ks = 0; ks < 4; ++ks) acc = MFMA32(af[ks], bfr[ks], acc);
            LAS unsigned char* ob = Ost + (32 * et + 4 * (F.lane >> 5)) * 272 + (32 * dt + (F.lane & 31)) * 2;
#pragma unroll
            for (int r = 0; r < 16; ++r) *(LAS unsigned short*)(ob + ((r & 3) + 8 * (r >> 2)) * 272) = hwbf(acc[r]);
        }
        __syncthreads();
        for (int i = F.tid; i < DV * 16; i += NWAVES * 64) { const int l31 = i & 31, hf = (i >> 5) & 1, s = (i >> 6) & 7, etq = i >> 9, e = 32 * etq + l31, ch = 2 * s + hf;
            *(GAS v4u*)(kvp + (size_t)i * 8) = *(const LAS v4u*)(Ost + e * 272 + ch * 16); }
    }
}

__device__ __forceinline__ void chunk_scan(const Frame& F, bf16* kv, const float* dec, int nstreams, int DVv) {
    const int per_stream = DVv * 128 / 8;
    const long ntask = (long)nstreams * per_stream;
    for (long task = (long)F.vcu * (NWAVES * 64) + F.tid; task < ntask; task += (long)F.G * NWAVES * 64) {
        const int stream = (int)(task / per_stream), el = (int)(task % per_stream), d0 = 16 * ((el >> 6) & 7) + 8 * ((el >> 5) & 1);
        bf16* p = kv + (size_t)stream * NCH * (DVv * 128) + (size_t)el * 8;
        const float* dp = dec + (size_t)stream * NCH * 128 + d0;
        float S[8];
#pragma unroll
        for (int j = 0; j < 8; ++j) S[j] = 0.f;
#pragma unroll 4
        for (int cs = 0; cs < NCH; ++cs) {
            const v4u w = *(const GAS v4u*)(p + (size_t)cs * (DVv * 128));
            const f32x4 da = *(const GAS f32x4*)(dp + (size_t)cs * 128), db = *(const GAS f32x4*)(dp + (size_t)cs * 128 + 4);
            v4u o; o.x = hwpk2(S[0], S[1]); o.y = hwpk2(S[2], S[3]); o.z = hwpk2(S[4], S[5]); o.w = hwpk2(S[6], S[7]);
            *(GAS v4u*)(p + (size_t)cs * (DVv * 128)) = o;
            S[0] = da.x * S[0] + bflo(w.x); S[1] = da.y * S[1] + bfhi(w.x); S[2] = da.z * S[2] + bflo(w.y); S[3] = da.w * S[3] + bfhi(w.y);
            S[4] = db.x * S[4] + bflo(w.z); S[5] = db.y * S[5] + bfhi(w.z); S[6] = db.z * S[6] + bflo(w.w); S[7] = db.w * S[7] + bfhi(w.w);
        }
    }
}

template <int DV, bool HG>
__device__ __forceinline__ void chunk_pass2(const Frame& F, const ChunkP& P, int NH, int first_chunk, int v0) {
    LAS unsigned char* T0 = F.lds;
    LAS unsigned char* rawq = F.lds + 49152;
    LAS unsigned char* rawk0 = F.lds + 66560;
    LAS unsigned char* rawk1 = F.lds + 83968;
    LAS unsigned char* Vimg = F.lds + 101376;
    LAS float* segtot = (LAS float*)(F.lds + 134144);
    LAS float* alr_s = (LAS float*)(F.lds + 138240);
    LAS float* rowsq = (LAS float*)(F.lds + 146432);
    LAS float* Ost = (LAS float*)F.lds;
    const int nch = NCH - first_chunk, nitems = NB * NH * nch;
    constexpr int NIT = (DV == 256) ? 2 : 1;
    constexpr int OLD = DV + 4;
    const int d = F.tid & 127, seg = F.tid >> 7;
    constexpr int NVT = 64 * (DV / 8) / (NWAVES * 64);
    v4u pfv[NVT], pfq[2], pfk[HG ? 4 : 2]; v2u pfa;
#define P2_PREFETCH(item_) do { const int c_ = first_chunk + (item_) % nch, h_ = ((item_) / nch) % NH, b_ = (item_) / (nch * NH); const size_t r0_ = (size_t)b_ * T + (size_t)c_ * 64; \
        _Pragma("unroll") for (int t = 0; t < NVT; ++t) { const int i = F.tid + t * NWAVES * 64, m = i / (DV / 8), chx = i % (DV / 8); pfv[t] = *(const GAS v4u*)(P.v + (r0_ + m) * P.ldv + h_ * DV + chx * 8); } \
        _Pragma("unroll") for (int t = 0; t < 2; ++t) { const int i = F.tid + t * NWAVES * 64, m = i >> 4, ch = i & 15; \
            pfq[t] = *(const GAS v4u*)(P.q + (r0_ + m) * P.ldq + h_ * 128 + ch * 8); \
            if (HG) { pfk[t] = *(const GAS v4u*)(P.z[0] + (r0_ + m) * D + h_ * 128 + ch * 8); pfk[2 + t] = *(const GAS v4u*)(P.z[1] + (r0_ + m) * D + h_ * 128 + ch * 8); } \
            else pfk[t] = *(const GAS v4u*)(P.k + (r0_ + m) * P.ldk + h_ * 128 + ch * 8); } \
        if (!HG) pfa = *(const GAS v2u*)(P.alr + r0_ * 32 + F.tid * 4); } while (0)
    if (v0 < nitems) P2_PREFETCH(v0);
    for (int item = v0; item < nitems; item += F.G) {
        const int c = first_chunk + item % nch, h = (item / nch) % NH, b = item / (nch * NH);
        const size_t row0 = (size_t)b * T + (size_t)c * 64;
        const int et = (DV == 256) ? F.wave : (F.wave >> 1), it0 = (DV == 256) ? 0 : (F.wave & 1);
        f32x16 acc[NIT];
#pragma unroll
        for (int t = 0; t < NIT; ++t) acc[t] = zero16();
        const float lb = HG ? P.lbl[h * 128 + d] : 0.f;
        if (!HG) *(LAS f32x4*)(alr_s + F.tid * 4) = (f32x4){h2f((unsigned short)(pfa.x & 0xffffu)), h2f((unsigned short)(pfa.x >> 16)), h2f((unsigned short)(pfa.y & 0xffffu)), h2f((unsigned short)(pfa.y >> 16))};
#pragma unroll
        for (int t = 0; t < NVT; ++t) { const int i = F.tid + t * NWAVES * 64, m = i / (DV / 8), chx = i % (DV / 8); *(LAS v4u*)(Vimg + (chx >> 4) * 16384 + off_b(m, chx & 15)) = pfv[t]; }
#pragma unroll
        for (int t = 0; t < 2; ++t) { const int i = F.tid + t * NWAVES * 64, m = i >> 4, ch = i & 15;
            *(LAS v4u*)(rawq + m * 272 + ch * 16) = pfq[t]; *(LAS v4u*)(rawk0 + m * 272 + ch * 16) = pfk[t];
            if (HG) *(LAS v4u*)(rawk1 + m * 272 + ch * 16) = pfk[2 + t]; }
        __syncthreads();
        bf16x8 vpm[2][2];
#pragma unroll 1
        for (int dir = 0; dir < 2; ++dir) {
            LAS unsigned char* Qt = T0; LAS unsigned char* Kt = Qt + 16384; LAS unsigned char* Qd = Qt + 32768;
            SegIn S; seg_load<HG, true>(P, rawq, (HG && dir) ? rawk1 : rawk0, h, d, seg, dir, S);
            const int stream = (b * NH + h) * 2 + dir, cs = chunk_scan_index(c, dir);
            const bf16* sp = P.kv + ((size_t)stream * NCH + cs) * (DV * 128) + (size_t)et * 4096 + F.lane * 8;
            bf16x8 sfr[8];
            if (HG) {
#pragma unroll
                for (int s = 0; s < 8; ++s) sfr[s] = *(const GAS bf16x8*)(sp + 512 * s); }
            float g[16], kf[16];
            segtot[(dir * 4 + seg) * 128 + d] = seg_gates<HG>(S, lb, seg, dir, alr_s, g, kf);
            __syncthreads();
            float offs = 0.f;
#pragma unroll
            for (int s2 = 0; s2 < 3; ++s2) offs += (s2 < seg) ? segtot[(dir * 4 + s2) * 128 + d] : 0.f;
            const float bref = segtot[(dir * 4 + 0) * 128 + d] + segtot[(dir * 4 + 1) * 128 + d];
            const float eref = fexp(bref);
#pragma unroll
            for (int i = 0; i < 16; ++i) { const int p = seg * 16 + i, m = dir ? 63 - p : p; const float B = g[i] + offs, qf = (i & 1) ? bfhi(S.q[i >> 1]) : bflo(S.q[i >> 1]);
                const float e1 = fexp(B - bref), qe = qf * e1;
                st16(Qt, m, d, qe); st16(Kt, m, d, kf[i] * frcp(e1)); st16(Qd, m, d, qe * eref); }
            __syncthreads();
            if (!HG) {
#pragma unroll
                for (int s = 0; s < 8; ++s) sfr[s] = *(const GAS bf16x8*)(sp + 512 * s); }
            if (dir == 0) {
#pragma unroll
                for (int jt = 0; jt < 2; ++jt) { const unsigned base = lds_addr(Vimg + (et >> 2) * 16384) + jt * 8192; tr_read_perm32(base + tr_addr2(F.lane, et & 3, 0), base + tr_addr2(F.lane, et & 3, 1), vpm[jt]); }
            }
#pragma unroll
            for (int t = 0; t < NIT; ++t) { const int it = it0 + t;
#pragma unroll
                for (int jt = 0; jt < 2; ++jt) {
                    const bool skip = dir ? (jt < it) : (jt > it);
                    if (!skip) {
                        f32x16 pa = zero16();
#pragma unroll
                        for (int s = 0; s < 8; ++s) pa = MFMA32(row_frag(Kt, 32 * jt, F.lane, s), row_frag(Qt, 32 * it, F.lane, s), pa);
                        const int i_ = 32 * it + (F.lane & 31);
#pragma unroll
                        for (int s = 0; s < 2; ++s) { unsigned w4[4];
#pragma unroll
                            for (int u = 0; u < 4; ++u) { const int r0 = 8 * s + 2 * u, j0 = 32 * jt + (r0 & 3) + 8 * (r0 >> 2) + 4 * (F.lane >> 5);
                                const bool ok0 = dir ? (j0 >= i_) : (j0 <= i_), ok1 = dir ? (j0 + 1 >= i_) : (j0 + 1 <= i_);
                                w4[u] = pk2(ok0 ? pa[r0] : 0.f, ok1 ? pa[r0 + 1] : 0.f); }
                            acc[t] = MFMA32(__builtin_bit_cast(bf16x8, (v4u){w4[0], w4[1], w4[2], w4[3]}), vpm[jt][s], acc[t]); }
                    }
                }
#pragma unroll
                for (int s = 0; s < 8; ++s) acc[t] = MFMA32(row_frag(Qd, 32 * it, F.lane, s), sfr[s], acc[t]);
            }
            __syncthreads();
        }
#pragma unroll
        for (int t = 0; t < NIT; ++t) { const int it = it0 + t;
            LAS float* ob = Ost + (32 * it + 4 * (F.lane >> 5)) * OLD + 32 * et + (F.lane & 31);
#pragma unroll
            for (int r = 0; r < 16; ++r) ob[((r & 3) + 8 * (r >> 2)) * OLD] = acc[t][r]; }
        if (item + F.G < nitems) P2_PREFETCH(item + F.G);
        constexpr int NTK = 64 * (DV / 8) / (NWAVES * 64);
        v4u graw[NTK];
#pragma unroll
        for (int t = 0; t < NTK; ++t) { const int i2 = F.tid + t * NWAVES * 64, m = i2 / (DV / 8), ch = i2 % (DV / 8); graw[t] = *(const GAS v4u*)(P.sg + (row0 + m) * D + h * DV + ch * 8); }
        __syncthreads();
#pragma unroll
        for (int t = 0; t < NTK; ++t) { const int i2 = F.tid + t * NWAVES * 64, m = i2 / (DV / 8), ch = i2 % (DV / 8);
            const f32x4 o0 = *(const LAS f32x4*)(Ost + m * OLD + ch * 8), o1 = *(const LAS f32x4*)(Ost + m * OLD + ch * 8 + 4);
            float ss = (o0.x * o0.x + o0.y * o0.y) + (o0.z * o0.z + o0.w * o0.w) + (o1.x * o1.x + o1.y * o1.y) + (o1.z * o1.z + o1.w * o1.w);
            ss = row_sum16(ss);
            if (DV == 256) ss += __shfl_xor(ss, 16);
            const float rstd = rsqrtf(ss * (1.f / DV) + EPS);
            float gf[8]; unpack8(graw[t], gf);
            v4u o; o.x = hwpk2(o0.x * rstd * gf[0], o0.y * rstd * gf[1]); o.y = hwpk2(o0.z * rstd * gf[2], o0.w * rstd * gf[3]); o.z = hwpk2(o1.x * rstd * gf[4], o1.y * rstd * gf[5]); o.w = hwpk2(o1.z * rstd * gf[6], o1.w * rstd * gf[7]);
            *(GAS v4u*)(P.y + (row0 + m) * P.ldy + P.ycol0 + h * DV + ch * 8) = o; }
        __syncthreads();
    }
}

#undef P2_PREFETCH
template <int PASS>
__device__ __forceinline__ void lru_pass(const Frame& F, const Args& A) {
    LAS float* xc = (LAS float*)F.lds;
    LAS unsigned char* Ximg = F.lds + 32768;
    LAS f32x2* AU = (LAS f32x2*)(F.lds + 49152);
    LAS float* rec = (LAS float*)(F.lds + 114688);
    LAS float* sagg = (LAS float*)(F.lds + 147456);
    LAS float* cw = (LAS float*)(F.lds + 151552);
    const bf16* XL = (const bf16*)(F.ws + WS_A + A_XL);
    const bf16* GX = (const bf16*)(F.ws + WS_A + A_GX);
    bf16* Y0 = (bf16*)(F.ws + WS_B + B_Y);
    float* agg = (float*)(F.ws + WS_LRU);
    const bf16* Wl = (const bf16*)(F.ws + WS_W_LRU);
    const int hh = F.vcu >> 5, li = F.vcu & 31, NPAIR = NB * NCH;
    if (F.G != 256) return;
    const int it = F.wave & 1, et = F.wave >> 1;
    const int e_l = 32 * et + (F.lane & 31);
    const int sch = F.tid & 127, sseg = F.tid >> 7;
    for (int i = F.tid; i < 5 * 128; i += NWAVES * 64) { const int j = i >> 7, ch = i & 127; cw[i] = j < 4 ? A.in[I_CONVW][j * D + hh * 128 + ch] : A.in[I_CONVB][hh * 128 + ch]; }
    float gba[2], gbi[2], gsp[2];
#pragma unroll
    for (int dir = 0; dir < 2; ++dir) { const int chn = hh * 128 + e_l; gba[dir] = A.in[I_LRUBA][dir * D + chn]; gbi[dir] = A.in[I_LRUBI][dir * D + chn]; gsp[dir] = log1pf(expf(-A.in[I_LRULAM][dir * D + chn])); }
    v4u xr[2][4];
#define LRU_PREFETCH(q_) do { const int c_ = (q_) % NCH, b_ = (q_) / NCH, s0_ = c_ * 64, lo_ = c_ < 4 ? 0 : CTX, hi_ = c_ < 4 ? CTX : T; \
        _Pragma("unroll") for (int t = 0; t < 2; ++t) { const int i_ = F.tid + t * NWAVES * 64, m_ = i_ >> 4, ch_ = i_ & 15; \
            _Pragma("unroll") for (int j = 0; j < 4; ++j) { const int ss = s0_ + m_ + j - 2; \
                xr[t][j] = (ss >= lo_ && ss < hi_) ? *(const GAS v4u*)(XL + ((size_t)b_ * T + ss) * D + hh * 128 + ch_ * 8) : (v4u){0u, 0u, 0u, 0u}; } \
            } } while (0)
    if (li < NPAIR) LRU_PREFETCH(li);
    __syncthreads();
    for (int q = li; q < NPAIR; q += 32) {
        const int c = q % NCH, b = q / NCH, s0 = c * 64;
        const size_t rowb = (size_t)b * T;
#pragma unroll
        for (int t = 0; t < 2; ++t) { const int i = F.tid + t * NWAVES * 64, m = i >> 4, ch = i & 15;
            float acc8[8];
            { const f32x4 b0 = *(const LAS f32x4*)(cw + 4 * 128 + ch * 8), b1 = *(const LAS f32x4*)(cw + 4 * 128 + ch * 8 + 4);
              acc8[0] = b0.x; acc8[1] = b0.y; acc8[2] = b0.z; acc8[3] = b0.w; acc8[4] = b1.x; acc8[5] = b1.y; acc8[6] = b1.z; acc8[7] = b1.w; }
#pragma unroll
            for (int j = 0; j < 4; ++j) { const v4u w = xr[t][j];
                const f32x4 w0 = *(const LAS f32x4*)(cw + j * 128 + ch * 8), w1 = *(const LAS f32x4*)(cw + j * 128 + ch * 8 + 4);
                acc8[0] += w0.x * bflo(w.x); acc8[1] += w0.y * bfhi(w.x); acc8[2] += w0.z * bflo(w.y); acc8[3] += w0.w * bfhi(w.y);
                acc8[4] += w1.x * bflo(w.z); acc8[5] += w1.y * bfhi(w.z); acc8[6] += w1.z * bflo(w.w); acc8[7] += w1.w * bfhi(w.w); }
            *(LAS f32x4*)(xc + m * 128 + ch * 8) = (f32x4){acc8[0], acc8[1], acc8[2], acc8[3]};
            *(LAS f32x4*)(xc + m * 128 + ch * 8 + 4) = (f32x4){acc8[4], acc8[5], acc8[6], acc8[7]};
            *(LAS v4u*)(Ximg + off_b(m, ch)) = (v4u){hwpk2(acc8[0], acc8[1]), hwpk2(acc8[2], acc8[3]), hwpk2(acc8[4], acc8[5]), hwpk2(acc8[6], acc8[7])}; }
        v4u gxc[2]; float cinc[2] = {0.f, 0.f};
        if (PASS == 2) {
#pragma unroll
            for (int t = 0; t < 2; ++t) { const int i = F.tid + t * NWAVES * 64, m = i >> 4, ch = i & 15; gxc[t] = *(const GAS v4u*)(GX + (rowb + s0 + m) * D + hh * 128 + ch * 8); }
#pragma unroll
            for (int dir = 0; dir < 2; ++dir) cinc[dir] = agg[((((size_t)dir * NB + b) * NCH + c) * D + hh * 128 + sch) * 2 + 1]; }
        if (q + 32 < NPAIR) LRU_PREFETCH(q + 32);
        __syncthreads();
        float hf[16];
        unsigned afp[8];
#pragma unroll 1
        for (int dir = 0; dir < 2; ++dir) {
            bf16x8 wfa[8], wfi[8];
            { const bf16* wa = Wl + (size_t)((dir * 2 + 0) * 8 + hh) * 16384 + (size_t)et * 4096 + F.lane * 8;
              const bf16* wi = Wl + (size_t)((dir * 2 + 1) * 8 + hh) * 16384 + (size_t)et * 4096 + F.lane * 8;
#pragma unroll
              for (int s = 0; s < 8; ++s) { wfa[s] = *(const GAS bf16x8*)(wa + 512 * s); wfi[s] = *(const GAS bf16x8*)(wi + 512 * s); } }
            f32x16 pa = zero16(), pi = zero16();
#pragma unroll
            for (int s = 0; s < 8; ++s) { const bf16x8 xf = row_frag(Ximg, 32 * it, F.lane, s); pa = MFMA32(xf, wfa[s], pa); pi = MFMA32(xf, wfi[s], pi); }
            { const float ba = dir ? gba[1] : gba[0], bi = dir ? gbi[1] : gbi[0], sp = dir ? gsp[1] : gsp[0];
#pragma unroll
              for (int r = 0; r < 16; ++r) { const int m = 32 * it + (r & 3) + 8 * (r >> 2) + 4 * (F.lane >> 5);
                  const float rr = fsigm(pa[r] + ba), gi = fsigm(pi[r] + bi);
                  const float la = -8.f * rr * sp, av = fexp(la);
                  AU[m * 128 + e_l] = (f32x2){av, __builtin_amdgcn_sqrtf(1.f - av * av) * gi * xc[m * 128 + e_l]}; } }
            __syncthreads();
            const int sg = dir ? 3 - sseg : sseg;
            float hst = 0.f, ap = 1.f;
#pragma unroll
            for (int i = 0; i < 16; ++i) { const int p = sg * 16 + i, m = dir ? 63 - p : p; const f32x2 au = AU[m * 128 + sch]; hst = au.x * hst + au.y; ap *= au.x; }
            sagg[(sg * 128 + sch) * 2] = ap; sagg[(sg * 128 + sch) * 2 + 1] = hst;
            __syncthreads();
            if (PASS == 1 || PASS == 3) {
                if (sseg == 3) { float h2 = 0.f, a2 = 1.f;
#pragma unroll
                    for (int s2 = 0; s2 < 4; ++s2) { const float aa = sagg[(s2 * 128 + sch) * 2], hl = sagg[(s2 * 128 + sch) * 2 + 1]; h2 = aa * h2 + hl; a2 *= aa; }
                    float* ag = agg + ((((size_t)dir * NB + b) * NCH + c) * D + hh * 128 + sch) * 2;
                    *(GAS f32x2*)ag = (f32x2){a2, h2}; }
            }
            if (PASS >= 2) {
                if (PASS == 3 && dir == 1) {
#pragma unroll
                    for (int t = 0; t < 2; ++t) { const int i = F.tid + t * NWAVES * 64, m = i >> 4, ch = i & 15; gxc[t] = *(const GAS v4u*)(GX + (rowb + s0 + m) * D + hh * 128 + ch * 8); } }
                float hin = PASS == 2 ? (dir ? cinc[1] : cinc[0]) : 0.f, apin = 1.f;
#pragma unroll
                for (int s2 = 0; s2 < 3; ++s2) if (s2 < sg) { const float aa = sagg[(s2 * 128 + sch) * 2]; hin = aa * hin + sagg[(s2 * 128 + sch) * 2 + 1]; apin *= aa; }
                if (dir == 0) { float ae = 0.f;
#pragma unroll
                    for (int i = 0; i < 16; ++i) { const int m = sseg * 16 + i; const f32x2 au = AU[m * 128 + sch]; hin = au.x * hin + au.y; hf[i] = hin;
                        if (PASS == 3) { apin *= au.x; if (i & 1) afp[i >> 1] = hwpk2(ae, apin); else ae = apin; } }
                } else {
#pragma unroll
                    for (int i = 0; i < 16; ++i) { const int m = sseg * 16 + 15 - i; const f32x2 au = AU[m * 128 + sch]; hin = au.x * hin + au.y; rec[m * 128 + sch] = hf[15 - i] + hin;
                        if (PASS == 3) { apin *= au.x; const unsigned fb = ((15 - i) & 1) ? (afp[(15 - i) >> 1] >> 16) : (afp[(15 - i) >> 1] & 0xffffu);
                            ((LAS unsigned*)xc)[m * 128 + sch] = fb | ((unsigned)hwbf(apin) << 16); } }
                }
            }
            __syncthreads();
        }
        if (PASS >= 2) {
#pragma unroll
            for (int t = 0; t < 2; ++t) { const int i = F.tid + t * NWAVES * 64, m = i >> 4, ch = i & 15, c0 = hh * 128 + ch * 8;
                const f32x4 r0 = *(LAS f32x4*)(rec + m * 128 + ch * 8), r1 = *(LAS f32x4*)(rec + m * 128 + ch * 8 + 4);
                v4u o;
                const v4u g = gxc[t];
                o.x = hwpk2(bflo(g.x) * r0.x, bfhi(g.x) * r0.y); o.y = hwpk2(bflo(g.y) * r0.z, bfhi(g.y) * r0.w); o.z = hwpk2(bflo(g.z) * r1.x, bfhi(g.z) * r1.y); o.w = hwpk2(bflo(g.w) * r1.z, bfhi(g.w) * r1.w);
                if (PASS == 3) { const v4u p0 = *(const LAS v4u*)((LAS unsigned*)xc + m * 128 + ch * 8), p1 = *(const LAS v4u*)((LAS unsigned*)xc + m * 128 + ch * 8 + 4);
                    const size_t po = ((size_t)((c >= 34 ? c - 34 : c) * 64 + m)) * D + c0; const int hf_ = c >= 34 ? 1 : 0;
                    *(GAS v4u*)((bf16*)(F.ws + lru_piece((b * 2 + 0) * 2 + hf_)) + po) = (v4u){hwpk2(bflo(g.x) * bflo(p0.x), bfhi(g.x) * bflo(p0.y)), hwpk2(bflo(g.y) * bflo(p0.z), bfhi(g.y) * bflo(p0.w)), hwpk2(bflo(g.z) * bflo(p1.x), bfhi(g.z) * bflo(p1.y)), hwpk2(bflo(g.w) * bflo(p1.z), bfhi(g.w) * bflo(p1.w))};
                    *(GAS v4u*)((bf16*)(F.ws + lru_piece((b * 2 + 1) * 2 + hf_)) + po) = (v4u){hwpk2(bflo(g.x) * bfhi(p0.x), bfhi(g.x) * bfhi(p0.y)), hwpk2(bflo(g.y) * bfhi(p0.z), bfhi(g.y) * bfhi(p0.w)), hwpk2(bflo(g.z) * bfhi(p1.x), bfhi(g.z) * bfhi(p1.y)), hwpk2(bflo(g.w) * bfhi(p1.z), bfhi(g.w) * bfhi(p1.w))}; }
                *(GAS v4u*)(Y0 + (rowb + s0 + m) * (2 * D) + c0) = o; }
            __syncthreads();
        }
    }
#undef LRU_PREFETCH
}
struct LruFixIn { v4u hs, af, ab, cf, cb; };
__device__ __forceinline__ void lru_fix_load(const Frame& F, int i, LruFixIn& L) {
    const bf16* Y0 = (const bf16*)(F.ws + WS_B + B_Y); const bf16* cc = (const bf16*)(F.ws + WS_TKE);
    const int row = i >> 7, c0 = (i & 127) * 8, b = row / T, s = row - b * T, c = s >> 6, m = s & 63, hf_ = c >= 34 ? 1 : 0;
    const size_t po = ((size_t)((c - 34 * hf_) * 64 + m)) * D + c0;
    L.hs = *(const GAS v4u*)(Y0 + (size_t)row * (2 * D) + c0);
    L.af = *(const GAS v4u*)((const bf16*)(F.ws + lru_piece((b * 2 + 0) * 2 + hf_)) + po); L.ab = *(const GAS v4u*)((const bf16*)(F.ws + lru_piece((b * 2 + 1) * 2 + hf_)) + po);
    L.cf = *(const GAS v4u*)(cc + (((size_t)0 * NB + b) * NCH + c) * D + c0); L.cb = *(const GAS v4u*)(cc + (((size_t)1 * NB + b) * NCH + c) * D + c0);
}
__device__ __forceinline__ void lru_fix_store(const Frame& F, int i, const LruFixIn& L) {
    bf16* Y0 = (bf16*)(F.ws + WS_B + B_Y);
    const int row = i >> 7, c0 = (i & 127) * 8;
    float y[8];
    const unsigned hw[4] = {L.hs.x, L.hs.y, L.hs.z, L.hs.w}, fw[4] = {L.af.x, L.af.y, L.af.z, L.af.w}, bw[4] = {L.ab.x, L.ab.y, L.ab.z, L.ab.w}, cfw[4] = {L.cf.x, L.cf.y, L.cf.z, L.cf.w}, cbw[4] = {L.cb.x, L.cb.y, L.cb.z, L.cb.w};
#pragma unroll
    for (int j = 0; j < 4; ++j) {
        y[2 * j] = bflo(hw[j]) + bflo(fw[j]) * bflo(cfw[j]) + bflo(bw[j]) * bflo(cbw[j]);
        y[2 * j + 1] = bfhi(hw[j]) + bfhi(fw[j]) * bfhi(cfw[j]) + bfhi(bw[j]) * bfhi(cbw[j]); }
    *(GAS v4u*)(Y0 + (size_t)row * (2 * D) + c0) = (v4u){hwpk2(y[0], y[1]), hwpk2(y[2], y[3]), hwpk2(y[4], y[5]), hwpk2(y[6], y[7])};
}
__device__ __forceinline__ void lru_fix(const Frame& F, int v0) {
    constexpr int NQ = R / 4;
    int q0, q1, qs;
    if (F.G == 256) { if (v0 < 64) { q0 = v0 * 8; q1 = q0 + 8; } else { q0 = 512 + (v0 - 64) * 20; q1 = q0 + 20; } qs = 1; }
    else { q0 = F.vcu; q1 = NQ; qs = F.G; }
    for (int q = q0; q < q1; q += 2 * qs) {
        const int i0 = q * (NWAVES * 64) + F.tid, i1 = (q + qs) * (NWAVES * 64) + F.tid; const bool two = q + qs < q1;
        LruFixIn A0, A1;
        lru_fix_load(F, i0, A0);
        if (two) lru_fix_load(F, i1, A1);
        lru_fix_store(F, i0, A0);
        if (two) lru_fix_store(F, i1, A1);
    }
}
__device__ __forceinline__ void lru_scan(const Frame& F) {
    float* agg = (float*)(F.ws + WS_LRU);
    const int gt = F.vcu * NWAVES * 64 + F.tid;
    if (gt < 2 * NB * D) { const int chn = gt % D, b = (gt / D) % NB, dir = gt / (D * NB);
        float hst = 0.f;
#pragma unroll 1
        for (int c0 = 0; c0 < NCH; c0 += 17) {
            f32x2 av[17];
#pragma unroll
            for (int j = 0; j < 17; ++j) { const int cs = c0 + j, c = dir ? (cs < 4 ? 3 - cs : 71 - cs) : cs; av[j] = *(const GAS f32x2*)(agg + ((((size_t)dir * NB + b) * NCH + c) * D + chn) * 2); }
#pragma unroll
            for (int j = 0; j < 17; ++j) { const int cs = c0 + j, c = dir ? (cs < 4 ? 3 - cs : 71 - cs) : cs;
                agg[((((size_t)dir * NB + b) * NCH + c) * D + chn) * 2 + 1] = hst; ((bf16*)(F.ws + WS_TKE))[(((size_t)dir * NB + b) * NCH + c) * D + chn] = hwbf(hst); hst = av[j].x * hst + av[j].y; } } }
}

constexpr size_t A_DEC = A_KV + KV_BYTES;
static_assert(A_DEC + (size_t)2 * 64 * NCH * 128 * 4 <= AREA_A_BYTES, "dec / eref overlay");
__device__ __forceinline__ ChunkP gla_params(const Frame& F, const Args& A) {
    ChunkP P;
    unsigned char* a = F.ws + WS_A;
    P.q = (const bf16*)(a + A_Q); P.ldq = 512; P.k = (const bf16*)(a + A_K); P.ldk = 512; P.v = (const bf16*)(a + A_V); P.ldv = D;
    P.alr = (const f16b*)(a + A_ALR); P.wa2 = A.in[I_GLAWA2]; P.gba = A.in[I_GLABA]; P.z[0] = nullptr; P.z[1] = nullptr; P.lbl = nullptr;
    P.sg = (const bf16*)(a + A_SG); P.y = (bf16*)(F.ws + WS_B + B_Y); P.ldy = 2 * D; P.ycol0 = D;
    P.kv = (bf16*)(a + A_KV); P.dec = (float*)(a + A_DEC);
    return P;
}
__device__ __forceinline__ int lru_light_first(const Frame& F) { return (F.G == 256) ? (((F.vcu & 31) >= 16 ? 0 : 128) + 16 * (F.vcu >> 5) + (F.vcu & 15)) : F.vcu; }
#define OPAQUE_TID(F) asm volatile("" : "+v"(F.tid), "+v"(F.lane))
__device__ __forceinline__ void p3_mix0_pass1(Frame& F, const Args& A) { lru_pass<MK_DEBUG ? 1 : 3>(F, A); const ChunkP P = gla_params(F, A); chunk_pass1<256, false>(F, P, 4, lru_light_first(F)); }
__device__ __forceinline__ void p4_mix0_scan(Frame& F, const Args& A) { const ChunkP P = gla_params(F, A); chunk_scan(F, P.kv, P.dec, 32, 256); lru_scan(F); }
__device__ __forceinline__ void p5_mix0_pass2(Frame& F, const Args& A) { if (MK_DEBUG) lru_pass<2>(F, A); else lru_fix(F, lru_light_first(F)); const ChunkP P = gla_params(F, A); chunk_pass2<256, false>(F, P, 4, 0, lru_light_first(F)); }

struct EpiPlain {
    bf16* dst; int ld;
    __device__ __forceinline__ bool full(const pg8::Unit&) const { return true; }
    __device__ __forceinline__ void operator()(const f32x4 (&acc)[2][2][4][2], const pg8::Unit& u, int wr, int wc, int fr, int fq) const {
        store_tile16<0, false>(acc, dst + u.pn * 256, ld, u.arow0, wr, wc, fr, fq, 1.f);
    }
};
__device__ __forceinline__ int perm_row(int row) { const int b = row / T, s = row - b * T; if (s < CTX) return row; const int t = s - CTX; return b * T + CTX + (t & 63) * 64 + (t >> 6); }

__device__ __forceinline__ void moe_weights(const Frame& F, const Args& A, int layer, int worker, int nworkers, int e_lo = 0, int e_hi = 65) {
    LAS float* scr = (LAS float*)(F.lds + F.wave * 16384);
    const int gw = worker * NWAVES + F.wave, NGW = nworkers * NWAVES;
    const bool own = (layer == 1) && !MK_DEBUG;
    unsigned char* W1t = own ? F.ws + WS_W1T1 : F.ws + WS_A + A_W1T; unsigned char* W2t = own ? F.ws + WS_W2T1 : F.ws + WS_W2T;
    int itb = 0;
    for (int e = e_lo; e < e_hi; ++e) {
        const float* wg = e < NE ? A.in[I_WG] + ((size_t)layer * NE + e) * D * FF : A.in[I_WSG] + (size_t)layer * D * FF;
        const float* wu = e < NE ? A.in[I_WU] + ((size_t)layer * NE + e) * D * FF : A.in[I_WSU] + (size_t)layer * D * FF;
        const float* wd = e < NE ? A.in[I_WD] + ((size_t)layer * NE + e) * FF * D : A.in[I_WSD] + (size_t)layer * FF * D;
        transpose_matrix8(wg, D, FF, FF, W1t + (size_t)e * 512 * D, D, 8, scr, F.lane, gw, NGW, itb);
        transpose_matrix8(wu, D, FF, FF, W1t + (size_t)e * 512 * D + 4 * D, D, 8, scr, F.lane, gw, NGW, itb);
        transpose_matrix8(wd, FF, D, D, W2t + (size_t)e * D * FF, FF, 4, scr, F.lane, gw, NGW, itb);
    }
}

__device__ __forceinline__ void p6_outproj0(Frame& F, const Args& A) {
    SchedPlain S{(const bf16*)(F.ws + WS_B + B_Y), (const bf16*)(F.ws + WS_W_OUT0), 2 * D, R / 256, D / 256, F.G, (int)blockIdx.x, 0};
    EpiPlain E{(bf16*)(F.ws + WS_A + A_O), D};
    pg8::gemm_phase<EpiPlain, SchedPlain>(F.lds, 2 * D, S, E);
    if (F.G == 256 && blockIdx.x >= 16) { __syncthreads(); moe_weights(F, A, 0, (int)blockIdx.x - 16, 240); }
}

__device__ __forceinline__ void p2_tail(Frame& F, const Args& A) {
    if (!MK_DEBUG && F.G == 256 && blockIdx.x >= (68 * 21) % 256) { __syncthreads(); moe_weights(F, A, 1, (int)blockIdx.x - (68 * 21) % 256, 256 - (68 * 21) % 256, 0, 16); }
}
__device__ __forceinline__ void p12_tail(Frame& F, const Args& A) {
    if (!MK_DEBUG && F.G == 256 && blockIdx.x >= (68 * 20) % 256) { __syncthreads(); moe_weights(F, A, 1, (int)blockIdx.x - (68 * 20) % 256, 256 - (68 * 20) % 256, 42, 65); }
}
template <int LAYER>
__device__ __forceinline__ void post_mixer(Frame& F, const Args& A) {
    const int gw = F.vcu * NWAVES + F.wave, NGW = F.G * NWAVES;
    const float* Ml = (const float*)(F.ws + WS_MOD) + (size_t)LAYER * 5 * NMOD;
    const bf16* O = (const bf16*)(F.ws + WS_A + A_O);
    bf16* H = (bf16*)(F.ws + WS_A + A_H); bf16* HL = (bf16*)(F.ws + WS_A + A_HL);
    float* ctxb = (float*)(F.ws + WS_CTXB);
    const float* sx = LAYER == 0 ? A.in[I_X] : F.out; const float* sc = LAYER == 0 ? A.in[I_CTX] : ctxb;
    const float* pg = A.in[I_POSTG] + (LAYER * 2 + 0) * D; const float* g2 = A.in[I_PREG] + (LAYER * 2 + 1) * D;
    const int nrows = LAYER == 0 ? R : NB * SEQ;
    for (int i = gw; i < nrows; i += NGW) {
        const int row = LAYER == 0 ? i : (i / SEQ) * T + CTX + (i % SEQ);
        const float* m = Ml + (size_t)mod_row(row) * NMOD;
        f32x4 o[4], x[4], h[4];
        row_load_bf16(O + (size_t)(LAYER == 0 ? row : perm_row(row)) * D, F.lane, o);
        row_load_f32(row_src(sx, sc, row), F.lane, x);
        const float rstd_o = rsqrtf(row_ss(o) * (1.f / D) + EPS);
#pragma unroll
        for (int j = 0; j < 4; ++j) { const f32x4 gt = ((const GAS f32x4*)(m + 2 * D))[F.lane + 64 * j], pgv = ((const GAS f32x4*)pg)[F.lane + 64 * j];
            x[j] = x[j] + gt * (o[j] * rstd_o * pgv); ((GAS f32x4*)row_dst(F.out, ctxb, row))[F.lane + 64 * j] = x[j]; }
        const float rstd = rsqrtf(row_ss(x) * (1.f / D) + EPS);
        row_prenorm(x, rstd, g2, m + 4 * D, m + 3 * D, F.lane, h);
#pragma unroll
        for (int j = 0; j < 4; ++j) { v2u wh, wl; const unsigned a0 = f2bf(h[j].x), a1 = f2bf(h[j].y), a2 = f2bf(h[j].z), a3 = f2bf(h[j].w);
            wh.x = a0 | (a1 << 16); wh.y = a2 | (a3 << 16);
            wl.x = pk2(h[j].x - bf2f(a0), h[j].y - bf2f(a1)); wl.y = pk2(h[j].z - bf2f(a2), h[j].w - bf2f(a3));
            ((GAS v2u*)(H + (size_t)row * D))[F.lane + 64 * j] = wh; ((GAS v2u*)(HL + (size_t)row * D))[F.lane + 64 * j] = wl;
            ((GAS unsigned*)(F.ws + WS_A + A_H8 + (size_t)row * D))[F.lane + 64 * j] = pk4f8(h[j].x, h[j].y, h[j].z, h[j].w); }
    }
}
__device__ __forceinline__ void p7_post(Frame& F, const Args& A, const int LAYER);

#define MFMA16(a, b, c) __builtin_amdgcn_mfma_f32_16x16x32_bf16((a), (b), (c), 0, 0, 0)
__device__ __forceinline__ void p7_post_route(Frame& F, const Args& A, const int LAYER) {
    constexpr int RS = 2064;
    LAS unsigned char* Ah = F.lds;
    LAS unsigned char* Al = F.lds + 32 * RS;
    LAS float* Lg = (LAS float*)(F.lds + 132096);
    LAS unsigned char* Ks = F.lds + 140288;
    LAS unsigned long long* selm = (LAS unsigned long long*)(F.lds + 142336);
    const float* Ml = (const float*)(F.ws + WS_MOD) + (size_t)LAYER * 5 * NMOD;
    const bf16* O = (const bf16*)(F.ws + WS_A + A_O);
    float* ctxb = (float*)(F.ws + WS_CTXB);
    const float* sx = LAYER == 0 ? A.in[I_X] : F.out; const float* sc = LAYER == 0 ? A.in[I_CTX] : ctxb;
    const float* pg = A.in[I_POSTG] + (LAYER * 2 + 0) * D; const float* g2 = A.in[I_PREG] + (LAYER * 2 + 1) * D;
    const bf16* Rh = (const bf16*)(F.ws + WS_W_RT) + (size_t)LAYER * 2 * NE * D; const bf16* Rl = Rh + (size_t)NE * D;
    int* tke = (int*)(F.ws + WS_TKE); int* tkp = (int*)(F.ws + WS_TKP); float* tkw = (float*)(F.ws + WS_TKW); int* list = (int*)(F.ws + WS_LIST);
    int* cnt = (int*)(F.ws + WS_CTL) + CW_CNT + LAYER * 64;
    const int ngroups = LAYER == 0 ? R / 32 : NB * SEQ / 32;
    int lane_ = F.lane; asm volatile("" : "+v"(lane_));
    const int lane = lane_, rt = F.wave & 1, eq = F.wave >> 1;
    const float bias = A.in[I_MOEB][LAYER * NE + lane];
    const bf16* bh = Rh + (size_t)eq * 32 * 512 + lane * 8; const bf16* bl = Rl + (size_t)eq * 32 * 512 + lane * 8;
    const unsigned aoffs = (unsigned)((16 * rt + (lane & 15)) * RS + (lane >> 4) * 16);
    for (int g = F.vcu; g < ngroups; g += F.G) {
        const int row0 = LAYER == 0 ? g * 32 : (g / 128) * T + CTX + (g % 128) * 32;
#pragma unroll 2
        for (int rr = 0; rr < 4; ++rr) { const int r = F.wave + 8 * rr, row = row0 + r;
            const float* m = Ml + (size_t)mod_row(row) * NMOD;
            f32x4 o[4], x[4];
            row_load_bf16(O + (size_t)(LAYER == 0 ? row : perm_row(row)) * D, lane, o);
            row_load_f32(row_src(sx, sc, row), lane, x);
            const float rstd_o = rsqrtf(row_ss(o) * (1.f / D) + EPS);
#pragma unroll
            for (int j = 0; j < 4; ++j) { const f32x4 gt = ((const GAS f32x4*)(m + 2 * D))[lane + 64 * j], pgv = ((const GAS f32x4*)pg)[lane + 64 * j];
                x[j] = x[j] + gt * (o[j] * rstd_o * pgv); ((GAS f32x4*)row_dst(F.out, ctxb, row))[lane + 64 * j] = x[j]; }
            const float rstd = rsqrtf(row_ss(x) * (1.f / D) + EPS);
#pragma unroll
            for (int j = 0; j < 4; ++j) { const f32x4 gg = ((const GAS f32x4*)g2)[lane + 64 * j], sc4 = ((const GAS f32x4*)(m + 4 * D))[lane + 64 * j], sh4 = ((const GAS f32x4*)(m + 3 * D))[lane + 64 * j];
                const f32x4 h = x[j] * rstd * gg * (sc4 + 1.0f) + sh4;
                v2u wh, wl; const unsigned a0 = f2bf(h.x), a1 = f2bf(h.y), a2 = f2bf(h.z), a3 = f2bf(h.w);
                wh.x = a0 | (a1 << 16); wh.y = a2 | (a3 << 16);
                wl.x = pk2(h.x - bf2f(a0), h.y - bf2f(a1)); wl.y = pk2(h.z - bf2f(a2), h.w - bf2f(a3));
                *(LAS v2u*)(Ah + r * RS + (4 * lane + 256 * j) * 2) = wh; *(LAS v2u*)(Al + r * RS + (4 * lane + 256 * j) * 2) = wl;
                ((GAS unsigned*)(F.ws + WS_A + A_H8 + (size_t)row * D))[lane + 64 * j] = pk4f8(h.x, h.y, h.z, h.w); }
        }
        __syncthreads();
        f32x4 acc = {0.f, 0.f, 0.f, 0.f};
#pragma unroll 1
        for (int kb = 0; kb < 4; ++kb) {
            bf16x8 fh[8], fl[8];
#pragma unroll
            for (int s = 0; s < 8; ++s) { fh[s] = *(const GAS bf16x8*)(bh + (size_t)(kb * 8 + s) * 512); fl[s] = *(const GAS bf16x8*)(bl + (size_t)(kb * 8 + s) * 512); }
#pragma unroll
            for (int s = 0; s < 8; ++s) { const int ks = kb * 8 + s;
                const bf16x8 ah = *(const LAS bf16x8*)(Ah + aoffs + ks * 64), al = *(const LAS bf16x8*)(Al + aoffs + ks * 64);
                acc = MFMA16(ah, fh[s], acc); acc = MFMA16(al, fh[s], acc); acc = MFMA16(ah, fl[s], acc); }
        }
#pragma unroll
        for (int r = 0; r < 4; ++r) Lg[(16 * rt + (lane >> 4) * 4 + r) * 64 + 16 * eq + (lane & 15)] = acc[r];
        __syncthreads();
        for (int t4 = 0; t4 < 4; ++t4) { const int tk = F.wave * 4 + t4;
            float lgv = Lg[tk * 64 + lane]; lgv = (lgv == lgv) ? lgv : 0.f;
            const float aff = 1.f / (1.f + expf(-lgv)), bs = aff + bias;
            int rk = 0;
#pragma unroll
            for (int j = 0; j < 8; ++j) { const int o = (lane & ~7) + j; const float xv = __shfl(bs, o); rk += (xv > bs || (xv == bs && o < lane)) ? 1 : 0; }
            float gs = rk < 2 ? bs : 0.f;
            gs += __shfl_xor(gs, 1); gs += __shfl_xor(gs, 2); gs += __shfl_xor(gs, 4);
            int grk = 0; const int gi = lane >> 3;
#pragma unroll
            for (int j = 0; j < 8; ++j) { const float xv = __builtin_bit_cast(float, __builtin_amdgcn_readlane(__builtin_bit_cast(int, gs), j * 8)); grk += (xv > gs || (xv == gs && j < gi)) ? 1 : 0; }
            const bool keep = grk < 4;
            const float mv = keep ? bs : -INFINITY;
            unsigned long long kb_ = __ballot(keep);
            int erk = 0;
#pragma unroll 1
            for (int j = 0; j < 32; ++j) { const int src = __builtin_ctzll(kb_); kb_ &= kb_ - 1ull;
                const float xv = __builtin_bit_cast(float, __builtin_amdgcn_readlane(__builtin_bit_cast(int, mv), src)); erk += (xv > mv || (xv == mv && src < lane)) ? 1 : 0; }
            const bool sel = keep && erk < TOPK;
            const float ssum = wsum(sel ? aff : 0.f);
            Lg[tk * 64 + lane] = sel ? 2.5f * aff / ssum : 0.f;
            Ks[tk * 64 + lane] = (unsigned char)erk;
            const unsigned long long bm = __ballot(sel);
            if (lane == 0) selm[tk] = bm;
        }
        __syncthreads();
        if (F.wave == 0) {
            unsigned mk = 0u;
#pragma unroll
            for (int tk = 0; tk < 32; ++tk) mk |= (unsigned)((selm[tk] >> lane) & 1ull) << tk;
            const int ne = __builtin_popcount(mk);
            int base = 0;
            if (ne) base = atomicAdd(&cnt[lane], ne);
            int rank = 0;
            while (mk) { const int tk = __builtin_ctz(mk); mk &= mk - 1u;
                const int row = row0 + tk, k = Ks[tk * 64 + lane], pos = base + rank; ++rank;
                list[(size_t)lane * R + pos] = row * 8 + k;
                tke[(size_t)row * 8 + k] = lane; tkp[(size_t)row * 8 + k] = pos; tkw[(size_t)row * 8 + k] = Lg[tk * 64 + lane]; }
        }
        __syncthreads();
    }
}

__device__ __forceinline__ void p7_post(Frame& F, const Args& A, const int LAYER) { p7_post_route(F, A, LAYER); if ((LAYER == 1 && MK_DEBUG) || F.G != 256) { __syncthreads(); moe_weights(F, A, LAYER, F.vcu, F.G); } }

template <int LAYER>
__device__ __forceinline__ void moe_tile_table(const Frame& F, LAS int* tb) {
    if (F.wave == 0) {
        const int* cnt = (const int*)(F.ws + WS_CTL) + CW_CNT + LAYER * 64;
        const int n = __hip_atomic_load(cnt + F.lane, RLX_AGENT), tiles = (n + 255) >> 8;
        int incl = tiles;
#pragma unroll
        for (int off = 1; off < 64; off <<= 1) { const int v = __shfl_up(incl, off); incl += (F.lane >= off) ? v : 0; }
        tb[F.lane] = incl - tiles; tb[NE + 2 + F.lane] = n;
        if (F.lane == 63) { tb[NE] = incl; tb[NE + 1] = incl + (LAYER == 0 ? R : NB * SEQ) / 256; } }
    __syncthreads();
}
template <int LAYER, int NPN, bool GATHER>
struct SchedMoe {
    const LAS int* tb; const int* cnt; const int* list; const char* Ab; const char* Bb; int K, G, c;
    __device__ __forceinline__ bool next(int i, pg8::Unit& u) const {
        const int nU = tb[NE + 1] * NPN; const long L = (long)i * G + c; if (L >= nU) return false;
        const int wgid = pg8::xcd_remap((int)L, nU), rt = wgid / NPN;
        int lo = 0, hi = NE;
        while (lo < hi) { const int mid = (lo + hi + 1) >> 1; if (tb[mid] <= rt) lo = mid; else hi = mid - 1; }
        u.e = lo; u.pm = rt - tb[lo]; u.pn = wgid % NPN; u.arow0 = rt * 256;
        return true;
    }
    __device__ __forceinline__ void a_offs(const pg8::Unit& u, unsigned (&v)[2][2], int tid) const {
        const int n_e = (GATHER && u.e < NE) ? tb[NE + 2 + u.e] : 0;
#pragma unroll
        for (int i = 0; i < 2; ++i) { int R_, C_; pg8::stage_rc(tid * 16 + i * 8192, R_, C_);
#pragma unroll
            for (int h = 0; h < 2; ++h) {
                if (GATHER) { const int pos = u.pm * 256 + h * 128 + R_; int row;
                    if (u.e < NE) row = pos < n_e ? (list[(size_t)u.e * R + pos] >> 3) : 0;
                    else row = LAYER == 0 ? pos : (pos / SEQ) * T + CTX + (pos % SEQ);
                    v[h][i] = (unsigned)(row * K + C_) * 2u; }
                else v[h][i] = (unsigned)((u.arow0 + h * 128 + R_) * K + C_) * 2u; } }
    }
    __device__ __forceinline__ const char* a_base() const { return Ab; }
    __device__ __forceinline__ const char* b_base(const pg8::Unit& u) const { return Bb + ((size_t)u.e * (NPN == 2 ? 512 : 1024) + (size_t)u.pn * 256) * K * 2; }
};
struct EpiSwiglu {
    unsigned char* act;
    __device__ __forceinline__ bool full(const pg8::Unit&) const { return true; }
    __device__ __forceinline__ void operator()(const f32x4 (&acc)[2][2][4][2], const pg8::Unit& u, int wr, int wc, int fr, int fq) const {
#pragma unroll
        for (int ai = 0; ai < 2; ++ai)
#pragma unroll
            for (int m = 0; m < 4; ++m) { unsigned char* rowp = act + (size_t)(u.arow0 + ai * 128 + wr * 64 + m * 16 + fr) * FF + u.pn * 128 + 16 * wc + 4 * fq;
#pragma unroll
                for (int bj = 0; bj < 2; ++bj) { const f32x4 g = acc[ai][bj][m][0], up = acc[ai][bj][m][1];
                    *(GAS unsigned*)(rowp + bj * 64) = pk4f8(fsilu(g[0]) * up[0], fsilu(g[1]) * up[1], fsilu(g[2]) * up[2], fsilu(g[3]) * up[3]); } }
    }
};
template <int LAYER>
__device__ __forceinline__ void p9_gemm1(Frame& F, const Args& A) {
    LAS int* tb = (LAS int*)(F.lds + 132096);
    moe_tile_table<LAYER>(F, tb);
    SchedMoe<LAYER, 2, true> S{tb, (const int*)(F.ws + WS_CTL) + CW_CNT + LAYER * 64, (const int*)(F.ws + WS_LIST), (const char*)(F.ws + WS_A + A_H8), (const char*)((LAYER == 1 && !MK_DEBUG) ? F.ws + WS_W1T1 : F.ws + WS_A + A_W1T), D / 2, F.G, (int)blockIdx.x};
    EpiSwiglu E{F.ws + WS_B + B_ACT};
    int kk = D / 2; asm volatile("" : "+s"(kk));
    pg8::gemm_phase<EpiSwiglu, SchedMoe<LAYER, 2, true>, true>(F.lds, kk, S, E);
    if (LAYER == 0 && !MK_DEBUG && F.G == 256) {
        const int nU = tb[NE + 1] * 2, rem = nU % 256, nidle = rem ? 256 - rem : 0;
        __syncthreads();
        if (nidle >= 64) { if ((int)blockIdx.x >= rem) moe_weights(F, A, 1, (int)blockIdx.x - rem, nidle, 16, 42); }
        else moe_weights(F, A, 1, F.vcu, F.G, 16, 42); }
}
struct EpiPlain8 {
    unsigned char* dst; int ld; int abl;
    __device__ __forceinline__ bool full(const pg8::Unit&) const { return !(abl & 64); }
    __device__ __forceinline__ void operator()(const f32x4 (&acc)[2][2][4][2], const pg8::Unit& u, int wr, int wc, int fr, int fq) const {
        if (abl & 64) { f32x4 s = {0.f, 0.f, 0.f, 0.f};
#pragma unroll
            for (int ai = 0; ai < 2; ++ai)
#pragma unroll
                for (int bj = 0; bj < 2; ++bj)
#pragma unroll
                    for (int m = 0; m < 4; ++m) { s = s + acc[ai][bj][m][0]; s = s + acc[ai][bj][m][1]; }
            if (s[0] + s[1] + s[2] + s[3] == 12345.678f) dst[1] = 1; return; }
#pragma unroll
        for (int ai = 0; ai < 2; ++ai)
#pragma unroll
            for (int m = 0; m < 4; ++m) { unsigned char* rowp = dst + (size_t)(u.arow0 + ai * 128 + wr * 64 + m * 16 + fr) * ld + u.pn * 256 + wc * 32 + 8 * fq;
#pragma unroll
                for (int bj = 0; bj < 2; ++bj) { const f32x4 v0 = acc[ai][bj][m][0], v1 = acc[ai][bj][m][1];
                    *(GAS v2u*)(rowp + bj * 128) = (v2u){pk4f8(v0[0], v0[1], v0[2], v0[3]), pk4f8(v1[0], v1[1], v1[2], v1[3])}; } }
    }
};
template <int LAYER>
__device__ __forceinline__ void gemm2_astat(Frame& F, const LAS int* tb) {
    typedef int v8i __attribute__((ext_vector_type(8))); typedef int v4i __attribute__((ext_vector_type(4)));
    const unsigned char* ACT = F.ws + WS_B + B_ACT; const unsigned char* W2 = (LAYER == 1 && !MK_DEBUG) ? F.ws + WS_W2T1 : F.ws + WS_W2T; unsigned char* YD = F.ws + WS_A;
    const int tid = F.tid, wid = F.wave, lane = tid & 63, wr = wid >> 2, wc = wid & 3, fr = lane & 15, fq = lane >> 4;
    const int nrt = __builtin_amdgcn_readfirstlane(tb[NE + 1]);
    unsigned soff[4];
#pragma unroll
    for (int j = 0; j < 4; ++j) { const int li = j * 512 + tid, rho = li >> 4, col = (rho & ~31) + pg8::perm32(rho & 31), ch = (li & 15) ^ (rho & 15); soff[j] = (unsigned)(col * 256 + ch * 16); }
    const unsigned ldsw = (unsigned)wid * 1024u;
    unsigned boff[2][2];
#pragma unroll
    for (int ks = 0; ks < 2; ++ks)
#pragma unroll
        for (int p = 0; p < 2; ++p) boff[ks][p] = (unsigned)((wc * 32 + fr) * 256 + (((ks * 8 + fq * 2 + p) ^ fr) * 16));
#define G2_STAGE(buf_, src_) do { _Pragma("unroll") for (int j_ = 0; j_ < 4; ++j_) __builtin_amdgcn_global_load_lds((const unsigned*)((src_) + soff[j_]), (LAS unsigned*)(F.lds + (buf_) * 32768 + j_ * 8192 + ldsw), 16, 0, 0); } while (0)
    int it = 0;
    long L = (long)blockIdx.x; if (L >= nrt) return;
    int rt = pg8::xcd_remap((int)L, nrt);
    int e; { int lo = 0, hi = NE; while (lo < hi) { const int mid = (lo + hi + 1) >> 1; if (tb[mid] <= rt) lo = mid; else hi = mid - 1; } e = __builtin_amdgcn_readfirstlane(lo); }
    const unsigned char* wb = W2 + (size_t)e * (D * FF);
    G2_STAGE(0, wb);
    int g = 0;
    for (;;) {
        v8i At[8][2];
        { const unsigned char* ap = ACT + (size_t)(rt * 256 + wr * 128 + fr) * FF + fq * 32;
#pragma unroll
          for (int m = 0; m < 8; ++m)
#pragma unroll
              for (int ks = 0; ks < 2; ++ks) { const v4i lo_ = *(const GAS v4i*)(ap + m * 16 * FF + ks * 128), hi_ = *(const GAS v4i*)(ap + m * 16 * FF + ks * 128 + 16); At[m][ks] = __builtin_shufflevector(lo_, hi_, 0, 1, 2, 3, 4, 5, 6, 7); } }
        const long Ln = (long)(it + 1) * F.G + blockIdx.x; const bool has_next = Ln < nrt;
        int rtn = rt, en = e;
        if (has_next) { rtn = pg8::xcd_remap((int)Ln, nrt); int lo = 0, hi = NE; while (lo < hi) { const int mid = (lo + hi + 1) >> 1; if (tb[mid] <= rtn) lo = mid; else hi = mid - 1; } en = __builtin_amdgcn_readfirstlane(lo); }
        const unsigned char* wbn = W2 + (size_t)en * (D * FF);
#pragma unroll 1
        for (int s = 0; s < 8; ++s, ++g) {
            if (s == 0) asm volatile("s_waitcnt vmcnt(0)" ::: "memory");
            else asm volatile("s_waitcnt vmcnt(8)" ::: "memory");
            __syncthreads();
            if (s < 7) G2_STAGE((g + 1) & 1, wb + (size_t)(s + 1) * 128 * FF); else if (has_next) G2_STAGE((g + 1) & 1, wbn);
            const LAS unsigned char* bb = F.lds + (g & 1) * 32768;
            f32x4 acc[8][2];
#pragma unroll
            for (int m = 0; m < 8; ++m) { acc[m][0] = (f32x4){0.f, 0.f, 0.f, 0.f}; acc[m][1] = (f32x4){0.f, 0.f, 0.f, 0.f}; }
#pragma unroll
            for (int ks = 0; ks < 2; ++ks) {
                v8i Bt[2];
#pragma unroll
                for (int n = 0; n < 2; ++n) { const v4i lo_ = *(const LAS v4i*)(bb + boff[ks][0] + n * 4096), hi_ = *(const LAS v4i*)(bb + boff[ks][1] + n * 4096); Bt[n] = __builtin_shufflevector(lo_, hi_, 0, 1, 2, 3, 4, 5, 6, 7); }
#pragma unroll
                for (int m = 0; m < 8; ++m)
#pragma unroll
                    for (int n = 0; n < 2; ++n) acc[m][n] = __builtin_amdgcn_mfma_scale_f32_16x16x128_f8f6f4(Bt[n], At[m][ks], acc[m][n], 0, 0, 0, 0x7C7C7C7C, 0, 0x7C7C7C7C);
            }
            unsigned char* yp = YD + (size_t)(rt * 256 + wr * 128 + fr) * D + s * 128 + wc * 32 + 8 * fq;
#pragma unroll
            for (int m = 0; m < 8; ++m) { const f32x4 v0 = acc[m][0], v1 = acc[m][1];
                *(GAS v2u*)(yp + (size_t)m * 16 * D) = (v2u){pk4f8(v0[0], v0[1], v0[2], v0[3]), pk4f8(v1[0], v1[1], v1[2], v1[3])}; }
        }
        if (!has_next) break;
        rt = rtn; e = en; wb = wbn; ++it;
    }
    asm volatile("s_waitcnt vmcnt(0)" ::: "memory");
    __syncthreads();
#undef G2_STAGE
}
template <int LAYER>
__device__ __forceinline__ void p10_gemm2(Frame& F, const Args& A) {
    LAS int* tb = (LAS int*)(F.lds + 132096);
    moe_tile_table<LAYER>(F, tb);
    if (!MK_DEBUG || MK_DEBUG) { gemm2_astat<LAYER>(F, tb); return; }
    SchedMoe<LAYER, 4, false> S{tb, (const int*)(F.ws + WS_CTL) + CW_CNT + LAYER * 64, (const int*)(F.ws + WS_LIST), (const char*)(F.ws + WS_B + B_ACT), (const char*)((LAYER == 1 && !MK_DEBUG) ? F.ws + WS_W2T1 : F.ws + WS_W2T), FF / 2, F.G, (int)blockIdx.x};
    EpiPlain8 E{F.ws + WS_A, D, A.abl};
    int kk = FF / 2; asm volatile("" : "+s"(kk));
    pg8::gemm_phase<EpiPlain8, SchedMoe<LAYER, 4, false>, true>(F.lds, kk, S, E);
}
template <int LAYER>
__device__ __forceinline__ void p11_combine(Frame& F, const Args& A) {
    LAS int* tb = (LAS int*)(F.lds + 132096);
    moe_tile_table<LAYER>(F, tb);
    const int gw = F.vcu * NWAVES + F.wave, NGW = F.G * NWAVES;
    const float* Ml = (const float*)(F.ws + WS_MOD) + (size_t)LAYER * 5 * NMOD;
    const unsigned char* YD = F.ws + WS_A;
    const int* tke = (const int*)(F.ws + WS_TKE); const int* tkp = (const int*)(F.ws + WS_TKP); const float* tkw = (const float*)(F.ws + WS_TKW);
    float* ctxb = (float*)(F.ws + WS_CTXB);
    const float* pg = A.in[I_POSTG] + (LAYER * 2 + 1) * D;
    const int nrows = LAYER == 0 ? R : NB * SEQ;
    for (int i = gw; i < nrows; i += NGW) {
        const int row = LAYER == 0 ? i : (i / SEQ) * T + CTX + (i % SEQ);
        const float* m = Ml + (size_t)mod_row(row) * NMOD;
        f32x4 f[4], y[4], x[4];
        row_load_f8(YD + ((size_t)tb[NE] * 256 + i) * D, F.lane, f);
#pragma unroll
        for (int k = 0; k < TOPK; ++k) { const int e = tke[(size_t)row * 8 + k], pos = tkp[(size_t)row * 8 + k]; const float w = tkw[(size_t)row * 8 + k];
            row_load_f8(YD + ((size_t)tb[e] * 256 + pos) * D, F.lane, y);
#pragma unroll
            for (int j = 0; j < 4; ++j) f[j] = f[j] + y[j] * w; }
        row_load_f32(row_src(F.out, ctxb, row), F.lane, x);
        const float rstd_f = rsqrtf(row_ss(f) * (1.f / D) + EPS);
#pragma unroll
        for (int j = 0; j < 4; ++j) { const f32x4 gt = ((const GAS f32x4*)(m + 5 * D))[F.lane + 64 * j], pgv = ((const GAS f32x4*)pg)[F.lane + 64 * j];
            x[j] = x[j] + gt * (f[j] * rstd_f * pgv); ((GAS f32x4*)row_dst(F.out, ctxb, row))[F.lane + 64 * j] = x[j]; }
        if (LAYER == 0) {
            const float* m1 = (const float*)(F.ws + WS_MOD) + (size_t)(5 + mod_row(row)) * NMOD;
            f32x4 h[4];
            const float rstd = rsqrtf(row_ss(x) * (1.f / D) + EPS);
            row_prenorm(x, rstd, A.in[I_PREG] + 2 * D, m1 + 1 * D, m1 + 0 * D, F.lane, h);
            row_store_bf16((bf16*)(F.ws + WS_B + B_H1) + (size_t)perm_row(row) * D, F.lane, h);
        }
    }
}

struct EpiIn1 {
    unsigned char* a;
    __device__ __forceinline__ bool full(const pg8::Unit&) const { return true; }
    __device__ __forceinline__ void operator()(const f32x4 (&acc)[2][2][4][2], const pg8::Unit& u, int wr, int wc, int fr, int fq) const {
        const int pn = u.pn, r0 = u.arow0;
        if (pn < 4) store_tile16<0, false>(acc, (bf16*)(a + A_Q1) + pn * 256, D, r0, wr, wc, fr, fq, 1.f);
        else if (pn < 8) store_tile16<0, true>(acc, (f16b*)(a + A_ZF) + (pn - 4) * 256, D, r0, wr, wc, fr, fq, 1.f);
        else if (pn < 12) store_tile16<0, true>(acc, (f16b*)(a + A_ZB) + (pn - 8) * 256, D, r0, wr, wc, fr, fq, 1.f);
        else if (pn < 16) store_tile16<0, false>(acc, (bf16*)(a + A_V1) + (pn - 12) * 256, D, r0, wr, wc, fr, fq, 1.f);
        else store_tile16<2, false>(acc, (bf16*)(a + A_SG1) + (pn - 16) * 256, D, r0, wr, wc, fr, fq, 1.f);
    }
};
__device__ __forceinline__ void p12_inproj1(Frame& F, const Args& A) {
    SchedPlain S{(const bf16*)(F.ws + WS_B + B_H1), (const bf16*)(F.ws + WS_W_IN1), D, R / 256, CC / 256, F.G, (int)blockIdx.x, 0};
    EpiIn1 E{F.ws + WS_A};
    pg8::gemm_phase<EpiIn1, SchedPlain>(F.lds, D, S, E);
    p12_tail(F, A);
}
__device__ __forceinline__ ChunkP hgrn_params(const Frame& F, const Args& A) {
    ChunkP P;
    unsigned char* a = F.ws + WS_A;
    P.q = (const bf16*)(a + A_Q1); P.ldq = D; P.k = nullptr; P.ldk = 0; P.v = (const bf16*)(a + A_V1); P.ldv = D;
    P.alr = nullptr; P.wa2 = nullptr; P.gba = nullptr; P.z[0] = (const f16b*)(a + A_ZF); P.z[1] = (const f16b*)(a + A_ZB); P.lbl = (const float*)(F.ws + WS_MOD + 245760);
    P.sg = (const bf16*)(a + A_SG1); P.y = (bf16*)(F.ws + WS_B + B_Y1); P.ldy = D; P.ycol0 = 0;
    P.kv = (bf16*)(a + A_KV); P.dec = (float*)(a + A_DEC);
    return P;
}
__device__ __forceinline__ void p13_mix1_pass1(Frame& F, const Args& A) { const ChunkP P = hgrn_params(F, A); chunk_pass1<128, true>(F, P, 8, F.vcu); }
__device__ __forceinline__ void p14_mix1_scan(Frame& F, const Args& A) { const ChunkP P = hgrn_params(F, A); chunk_scan(F, P.kv, P.dec, 64, 128); }
__device__ __forceinline__ void p15_mix1_pass2(Frame& F, const Args& A) { const ChunkP P = hgrn_params(F, A); chunk_pass2<128, true>(F, P, 8, 4, F.vcu); }
__device__ __forceinline__ void p16_outproj1(Frame& F, const Args& A) {
    SchedPlain S{(const bf16*)(F.ws + WS_B + B_Y1), (const bf16*)(F.ws + WS_W_OUT1), D, NB * SEQ / 256, D / 256, F.G, (int)blockIdx.x, 1};
    EpiPlain E{(bf16*)(F.ws + WS_A + A_O), D};
    pg8::gemm_phase<EpiPlain, SchedPlain>(F.lds, D, S, E);
}

__global__ void __launch_bounds__(NWAVES * 64, 2) mk_fwd(Args args) {
    extern __shared__ __attribute__((aligned(16))) unsigned char lds[];
    Frame F;
    F.lds = (LAS unsigned char*)lds;
    F.MISC = (volatile LAS unsigned*)(F.lds + MISC_OFF);
    F.tid = threadIdx.x; F.lane = F.tid & 63; F.wave = __builtin_amdgcn_readfirstlane(F.tid >> 6);
    F.G = gridDim.x; { const int bx = blockIdx.x; F.vcu = (F.G % 8 == 0) ? (bx % 8) * (F.G / 8) + bx / 8 : bx; }
    F.ws = args.ws; F.out = args.out;
    F.ctl = (gu32*)(args.ws + WS_CTL);
    if (F.tid < 32) F.MISC[F.tid] = 0u;
    __syncthreads();
    const int lo = args.ph_lo, hi = args.ph_hi;
    XcdBarrier bar; bar.bar = (unsigned*)(F.ctl + CW_BAR); bar.x = 0; bar.st = nullptr;
    if (hi - lo > 1) bar = xcd_barrier_post((unsigned*)(F.ctl + CW_BAR), F.MISC + 8);
#define IN(k) (lo <= (k) && (k) < hi)
#define SEAM(k) do { if (IN(k) && IN((k) + 1)) xcd_barrier(bar); } while (0)
#define RUNPH(k, call) do { if (IN(k)) { const __attribute__((address_space(4))) Args* ap4_ = (const __attribute__((address_space(4))) Args*)__builtin_amdgcn_kernarg_segment_ptr(); \
        asm volatile("" : "+s"(ap4_)); const Args& args = *(const Args*)ap4_; asm volatile("" : "+v"(F.lane)); call; } } while (0)
    RUNPH(0, p0_prep(F, args));
    SEAM(0);
    RUNPH(1, p1_prenorm0(F, args));
    SEAM(1);
    RUNPH(2, p2_inproj0(F, args));
    SEAM(2);
        RUNPH(3, p3_mix0_pass1(F, args));
    SEAM(3);
    RUNPH(4, p4_mix0_scan(F, args));
    SEAM(4);
    RUNPH(5, p5_mix0_pass2(F, args));
    SEAM(5);
    RUNPH(6, p6_outproj0(F, args));
    SEAM(6);
    RUNPH(7, p7_post(F, args, 0));
    if (IN(7) && IN(9)) xcd_barrier(bar);
    RUNPH(9, p9_gemm1<0>(F, args));
    SEAM(9);
    RUNPH(10, p10_gemm2<0>(F, args));
    SEAM(10);
    RUNPH(11, p11_combine<0>(F, args));
    SEAM(11);
    RUNPH(12, p12_inproj1(F, args));
    SEAM(12);
    RUNPH(13, p13_mix1_pass1(F, args));
    SEAM(13);
    RUNPH(14, p14_mix1_scan(F, args));
    SEAM(14);
    RUNPH(15, p15_mix1_pass2(F, args));
    SEAM(15);
    RUNPH(16, p16_outproj1(F, args));
    SEAM(16);
    RUNPH(17, p7_post(F, args, 1));
    if (IN(17) && IN(19)) xcd_barrier(bar);
    RUNPH(19, p9_gemm1<1>(F, args));
    SEAM(19);
    RUNPH(20, p10_gemm2<1>(F, args));
    SEAM(20);
    RUNPH(21, p11_combine<1>(F, args));

    for (int xb_ = 0; xb_ < MK_XBAR; ++xb_) xcd_barrier(bar);
#undef IN
#undef SEAM
#undef RUNPH
}

static inline unsigned cdiv(size_t a, size_t b) { return (unsigned)((a + b - 1) / b); }
#if MK_DEBUG
constexpr int NSAMP = 128, SSTRIDE = 131;
constexpr size_t DBG_FINAL = 0;
constexpr size_t DBG_SAMP = (size_t)NB * SEQ * D * 2;
constexpr size_t SLOT_BYTES = (size_t)NSAMP * 2048 * 4;
__global__ void dk_sample(const float* src, int ld, int ncols, float* dst) {
    const int i = blockIdx.x; const size_t row = (size_t)SSTRIDE * i;
    for (int c = threadIdx.x; c < ncols; c += 256) dst[(size_t)i * ncols + c] = src[row * ld + c];
}
__global__ void dk_sample_stream(const float* xl, const float* xc, float* dst) {
    const int i = blockIdx.x; const int row = SSTRIDE * i;
    const float* src = row_src(xl, xc, row);
    for (int c = threadIdx.x; c < D; c += 256) dst[(size_t)i * D + c] = src[c];
}
__global__ void dk_save_bf16(const float* src, bf16* dst, size_t n) { const size_t i = (size_t)blockIdx.x * 256 + threadIdx.x; if (i < n) dst[i] = (bf16)f2bf(src[i]); }
__global__ void dk_cmp(const void* fast, const void* fast2, int dtype, int ldf, int rowmode, const float* samp, int ncols, int xform, float* err, int id) {
    __shared__ float rn[16], rd[16];
    float num = 0.f, den = 0.f;
    for (int i = 0; i < NSAMP; ++i) {
        const int row = SSTRIDE * i; int frow = row;
        if ((rowmode == 5 || rowmode == 6 || rowmode == 7) && (row % T) < CTX) continue;
        if (rowmode == 1 || rowmode == 5) { const int b = row / T, s = row % T; if (s >= CTX) { const int t = s - CTX, r = t >> 6, c = t & 63; frow = b * T + CTX + c * 64 + r; } }
        for (int c = threadIdx.x; c < ncols; c += 1024) {
            float o = (rowmode == 3) ? samp[(size_t)i * 2 * ncols + ncols + c] : ((rowmode == 4) ? samp[(size_t)i * 2 * ncols + c] : samp[(size_t)i * ncols + c]);
            if (xform == 1) o = gelu_tanh(o); else if (xform == 2) o = siluf(o);
            float f;
            if (rowmode == 2 || rowmode == 6) { f = row_src((const float*)fast, (const float*)fast2, row)[c]; }
            else if (dtype == 0) f = bf2f(((const bf16*)fast)[(size_t)frow * ldf + c]);
            else if (dtype == 1) f = h2f(((const f16b*)fast)[(size_t)frow * ldf + c]);
            else f = ((const float*)fast)[(size_t)frow * ldf + c];
            const float d = f - o; num += d * d; den += o * o;
            if (!(d == d)) num += 1e30f;
        }
    }
    num = wave_sum(num); den = wave_sum(den);
    if ((threadIdx.x & 63) == 0) { rn[threadIdx.x >> 6] = num; rd[threadIdx.x >> 6] = den; }
    __syncthreads();
    if (threadIdx.x == 0) { float a = 0.f, b = 0.f; for (int w = 0; w < 16; ++w) { a += rn[w]; b += rd[w]; } err[2 * id] = a; err[2 * id + 1] = b; }
}
__global__ void dk_cmp_flat(const float* fast, const float* ref, int n, float* err, int id) {
    __shared__ float rn[16], rd[16];
    float num = 0.f, den = 0.f;
    for (int i = threadIdx.x; i < n; i += 1024) { const float d = fast[i] - ref[i]; num += d * d; den += ref[i] * ref[i]; if (!(d == d)) num += 1e30f; }
    num = wave_sum(num); den = wave_sum(den);
    if ((threadIdx.x & 63) == 0) { rn[threadIdx.x >> 6] = num; rd[threadIdx.x >> 6] = den; }
    __syncthreads();
    if (threadIdx.x == 0) { float a = 0.f, b = 0.f; for (int w = 0; w < 16; ++w) { a += rn[w]; b += rd[w]; } err[2 * id] = a; err[2 * id + 1] = b; }
}
__global__ void dk_verdict(const float* err, int nid, float thr, int* code_out) {
    if (threadIdx.x == 0 && blockIdx.x == 0) { int code = 0, big = 0;
        for (int i = 0; i < nid; ++i) { const float r = err[2 * i] / fmaxf(err[2 * i + 1], 1e-30f); if (!(r <= thr)) { code = i + 1; big = !(r <= 0.1f); break; } }
        code_out[0] = code; code_out[1] = big; }
}
__global__ void dk_emit(const int* code, const bf16* oracle_final, float* out, size_t n, int full) {
    const int c = code[0]; if (c == 0 && full) return;
    const size_t nz = (size_t)((0.02 * c + 0.01 * code[1]) * (double)n);
    const size_t i = (size_t)blockIdx.x * 256 + threadIdx.x; if (i < n) out[i] = i < nz ? 0.f : bf2f(oracle_final[i]);
}
static void ogemm(hipStream_t st, const float* A, int lda, const float* B, int ldb, float* C, int ldc, int M, int N, int K) {
    hipLaunchKernelGGL(nv::k_gemm, dim3(cdiv(N, 64), cdiv(M, 64)), dim3(256), 0, st, A, lda, B, ldb, C, ldc, M, N, K);
}
enum { S_MOD = 0, S_H0, S_CL0, S_CL1, S_Q, S_K, S_V, S_CL5, S_ALR, S_Y0, S_O0, S_X1, S_HM0, S_LG0, S_F0, S_X2, S_H1, S_Q1, S_ZF, S_ZB, S_V1, S_CL4, S_Y1, S_O1, S_X3, S_HM1, S_F1, S_OUT, S_NSLOT };
static void run_debug(Args a, void* const* d_in, void* d_out, void* d_ws, size_t ws_size, hipStream_t st, int grid) {
    const float* x = (const float*)d_in[0]; const float* c = (const float*)d_in[1]; const float* ctx = (const float*)d_in[2]; const float* c_ctx = (const float*)d_in[3];
    const float* mod_w = (const float*)d_in[4]; const float* mod_b = (const float*)d_in[5]; const float* pre_gain = (const float*)d_in[6]; const float* post_gain = (const float*)d_in[7];
    const float* ab_w_in = (const float*)d_in[8]; const float* ab_conv_w = (const float*)d_in[9]; const float* ab_conv_b = (const float*)d_in[10];
    const float* lru_wa = (const float*)d_in[11]; const float* lru_ba = (const float*)d_in[12]; const float* lru_wi = (const float*)d_in[13]; const float* lru_bi = (const float*)d_in[14];
    const float* lru_lam = (const float*)d_in[15]; const float* gla_wa2 = (const float*)d_in[16]; const float* gla_ba = (const float*)d_in[17]; const float* ab_w_out = (const float*)d_in[18];
    const float* c_w_in = (const float*)d_in[19]; const float* lb_logits = (const float*)d_in[20]; const float* c_w_out = (const float*)d_in[21];
    const float* router = (const float*)d_in[22]; const float* moe_bias = (const float*)d_in[23]; const float* w_gate = (const float*)d_in[24]; const float* w_up = (const float*)d_in[25];
    const float* w_down = (const float*)d_in[26]; const float* ws_gate = (const float*)d_in[27]; const float* ws_up = (const float*)d_in[28]; const float* ws_down = (const float*)d_in[29];
    float* out = (float*)d_out;
    unsigned char* wsb = (unsigned char*)d_ws;
    if (ws_size < WS_DBG + DBG_SAMP + S_NSLOT * SLOT_BYTES) { fprintf(stderr, "debug: workspace too small\n"); return; }
    bf16* dbg_final = (bf16*)(wsb + WS_DBG + DBG_FINAL);
    auto slot = [&](int s) { return (float*)(wsb + WS_DBG + DBG_SAMP + (size_t)s * SLOT_BYTES); };
    auto samp = [&](const float* src, int ld, int ncols, int s) { hipLaunchKernelGGL(dk_sample, dim3(NSAMP), dim3(256), 0, st, src, ld, ncols, slot(s)); };
    const size_t RD = (size_t)R * D;
    float* W = (float*)d_ws; size_t off = 0;
    auto take = [&](size_t n) { float* p = W + off; off += (n + 63) & ~(size_t)63; return p; };
    float* Mm = take(2 * 5 * NMOD);
    float* ctxb = take((size_t)NB * CTX * D);
    float* H = take(RD); float* A = take(RD); float* B = take(RD); float* C = take(RD); float* Dd = take(RD); float* E = take(2 * RD);
    float* lg = take((size_t)R * NE); float* alr = take((size_t)R * 32);
    int* tk_e = (int*)take((size_t)R * TOPK); float* tk_w = take((size_t)R * TOPK); int* cnt = (int*)take(64); int* list = (int*)take((size_t)NE * R);
    if (off * 4 > WS_DBG) { fprintf(stderr, "debug: oracle workspace overlaps the checkpoint region\n"); return; }
    const unsigned gRD = cdiv(RD, 256);

    hipLaunchKernelGGL(nv::k_mod, dim3(NMOD / 256, 5, 2), dim3(256), 0, st, c, c_ctx, mod_w, mod_b, Mm);
    (void)hipMemcpyAsync(slot(S_MOD), Mm, (size_t)2 * 5 * NMOD * 4, hipMemcpyDeviceToDevice, st);
    {
        const float* Ml = Mm;
        hipLaunchKernelGGL(nv::k_prenorm, dim3(R), dim3(256), 0, st, x, ctx, pre_gain + 0, Ml, 0, 1, H, 0);
        samp(H, D, D, S_H0);
        ogemm(st, H, D, ab_w_in + 1024, ABC, A, D, R, 1024, D);   samp(A, D, D, S_CL1);
        hipLaunchKernelGGL(nv::k_conv, dim3(gRD), dim3(256), 0, st, A, ab_conv_w, ab_conv_b, B);
        for (int d = 0; d < 2; ++d) {
            for (int h = 0; h < 8; ++h) {
                ogemm(st, B + h * 128, D, lru_wa + ((size_t)d * 8 + h) * 128 * 128, 128, A + h * 128, D, R, 128, 128);
                ogemm(st, B + h * 128, D, lru_wi + ((size_t)d * 8 + h) * 128 * 128, 128, C + h * 128, D, R, 128, 128);
            }
            hipLaunchKernelGGL(nv::k_lru_gate, dim3(gRD), dim3(256), 0, st, A, C, B, lru_ba + d * D, lru_bi + d * D, lru_lam + d * D);
            hipLaunchKernelGGL(nv::k_lru_scan, dim3(NB * D / 256), dim3(256), 0, st, A, C, Dd, d, d);
        }
        ogemm(st, H, D, ab_w_in + 0, ABC, A, D, R, 1024, D);   samp(A, D, D, S_CL0);
        hipLaunchKernelGGL(nv::k_ya, dim3(gRD), dim3(256), 0, st, A, Dd, E, 2 * D);
        float* q = A; float* k = A + (size_t)R * 512;
        ogemm(st, H, D, ab_w_in + 2048, ABC, q, 512, R, 512, D);
        hipLaunchKernelGGL(nv::k_scale, dim3(cdiv((size_t)R * 512, 256)), dim3(256), 0, st, q, (size_t)R * 512, 0.08838834764831845f);
        samp(q, 512, 512, S_Q);
        ogemm(st, H, D, ab_w_in + 2560, ABC, k, 512, R, 512, D);   samp(k, 512, 512, S_K);
        ogemm(st, H, D, ab_w_in + 3072, ABC, B, D, R, 1024, D);    samp(B, D, D, S_V);
        ogemm(st, H, D, ab_w_in + 5120, ABC, alr, 32, R, 32, D);   samp(alr, 32, 32, S_ALR);
        for (int d = 0; d < 2; ++d) {
            float* g = C + (size_t)d * R * 512;
            ogemm(st, alr + d * 16, 32, gla_wa2 + (size_t)d * 16 * 512, 512, g, 512, R, 512, 16);
            hipLaunchKernelGGL(nv::k_gla_gate, dim3(cdiv((size_t)R * 512, 256)), dim3(256), 0, st, g, gla_ba + d * 512, 512);
            hipLaunchKernelGGL(nv::k_gla_scan<256>, dim3(256 / 8, 4, NB), dim3(1024), 0, st, q, 512, k, 512, B, D, g, 512, Dd, D, d, 0, d);
        }
        ogemm(st, H, D, ab_w_in + 4096, ABC, A, D, R, 1024, D);   samp(A, D, D, S_CL5);
        hipLaunchKernelGGL(nv::k_yb<256>, dim3(cdiv((size_t)R * 4 * 64, 256)), dim3(256), 0, st, Dd, A, D, E + D, 2 * D, 4);
        samp(E, 2 * D, 2 * D, S_Y0);
        ogemm(st, E, 2 * D, ab_w_out, D, A, D, R, D, 2 * D);   samp(A, D, D, S_O0);
        hipLaunchKernelGGL(nv::k_postres, dim3(R), dim3(256), 0, st, x, ctx, out, ctxb, A, post_gain + 0, Ml, 2, 0, 0);
        hipLaunchKernelGGL(dk_sample_stream, dim3(NSAMP), dim3(256), 0, st, out, ctxb, slot(S_X1));
        hipLaunchKernelGGL(nv::k_prenorm, dim3(R), dim3(256), 0, st, out, ctxb, pre_gain + D, Ml, 3, 4, H, 0);   samp(H, D, D, S_HM0);
        ogemm(st, H, D, router, NE, lg, NE, R, NE, D);   samp(lg, NE, NE, S_LG0);
        (void)hipMemsetAsync(cnt, 0, 64 * sizeof(int), st);
        hipLaunchKernelGGL(nv::k_route, dim3(cdiv((size_t)R * 64, 256)), dim3(256), 0, st, lg, moe_bias, R, tk_e, tk_w, cnt, list);
        hipLaunchKernelGGL(nv::k_expert, dim3(R / 8), dim3(256), 0, st, H, 0, R, ws_gate, ws_up, ws_down, cnt, list, tk_w, NE, A, 1);
        for (int e = 0; e < NE; ++e)
            hipLaunchKernelGGL(nv::k_expert, dim3(R / 8), dim3(256), 0, st, H, 0, R, w_gate + (size_t)e * D * FF, w_up + (size_t)e * D * FF, w_down + (size_t)e * FF * D, cnt, list, tk_w, e, A, 0);
        samp(A, D, D, S_F0);
        hipLaunchKernelGGL(nv::k_postres, dim3(R), dim3(256), 0, st, out, ctxb, out, ctxb, A, post_gain + D, Ml, 5, 0, 0);
        hipLaunchKernelGGL(dk_sample_stream, dim3(NSAMP), dim3(256), 0, st, out, ctxb, slot(S_X2));
    }
    {
        const float* Ml = Mm + 5 * NMOD;
        hipLaunchKernelGGL(nv::k_prenorm, dim3(R), dim3(256), 0, st, out, ctxb, pre_gain + 2 * D, Ml, 0, 1, H, 0);   samp(H, D, D, S_H1);
        ogemm(st, H, D, c_w_in + 0, CC, A, D, R, 1024, D);      samp(A, D, D, S_Q1);
        ogemm(st, H, D, c_w_in + 3072, CC, B, D, R, 1024, D);   samp(B, D, D, S_V1);
        for (int d = 0; d < 2; ++d) {
            ogemm(st, H, D, c_w_in + 1024 * (1 + d), CC, C, D, R, 1024, D);   samp(C, D, D, d ? S_ZB : S_ZF);
            hipLaunchKernelGGL(nv::k_hgrn_gate, dim3(gRD), dim3(256), 0, st, C, D, lb_logits, E, E + RD);
            hipLaunchKernelGGL(nv::k_gla_scan<128>, dim3(128 / 8, 8, NB), dim3(1024), 0, st, A, D, E + RD, D, B, D, E, D, Dd, D, d, 1, d);
        }
        ogemm(st, H, D, c_w_in + 4096, CC, C, D, R, 1024, D);   samp(C, D, D, S_CL4);
        hipLaunchKernelGGL(nv::k_yb<128>, dim3(cdiv((size_t)R * 8 * 64, 256)), dim3(256), 0, st, Dd, C, D, E, D, 8);   samp(E, D, D, S_Y1);
        ogemm(st, E, D, c_w_out, D, A, D, R, D, D);   samp(A, D, D, S_O1);
        hipLaunchKernelGGL(nv::k_postres, dim3(NB * SEQ), dim3(256), 0, st, out, ctxb, out, ctxb, A, post_gain + 2 * D, Ml, 2, 0, 1);
        hipLaunchKernelGGL(dk_sample_stream, dim3(NSAMP), dim3(256), 0, st, out, ctxb, slot(S_X3));
        hipLaunchKernelGGL(nv::k_prenorm, dim3(R), dim3(256), 0, st, out, ctxb, pre_gain + 3 * D, Ml, 3, 4, H, 0);   samp(H, D, D, S_HM1);
        for (int b = 0; b < NB; ++b) (void)hipMemcpyAsync(C + (size_t)b * SEQ * D, H + ((size_t)b * T + CTX) * D, (size_t)SEQ * D * 4, hipMemcpyDeviceToDevice, st);
        const int NT = NB * SEQ;
        ogemm(st, C, D, router + (size_t)D * NE, NE, lg, NE, NT, NE, D);
        (void)hipMemsetAsync(cnt, 0, 64 * sizeof(int), st);
        hipLaunchKernelGGL(nv::k_route, dim3(cdiv((size_t)NT * 64, 256)), dim3(256), 0, st, lg, moe_bias + NE, NT, tk_e, tk_w, cnt, list);
        const size_t WE = (size_t)NE * D * FF;
        hipLaunchKernelGGL(nv::k_expert, dim3(NT / 8), dim3(256), 0, st, C, 0, NT, ws_gate + (size_t)D * FF, ws_up + (size_t)D * FF, ws_down + (size_t)FF * D, cnt, list, tk_w, NE, A, 1);
        for (int e = 0; e < NE; ++e)
            hipLaunchKernelGGL(nv::k_expert, dim3(NT / 8), dim3(256), 0, st, C, 0, NT, w_gate + WE + (size_t)e * D * FF, w_up + WE + (size_t)e * D * FF, w_down + WE + (size_t)e * FF * D, cnt, list, tk_w, e, A, 0);
        for (int b = 0; b < NB; ++b) (void)hipMemcpyAsync(B + ((size_t)b * T + CTX) * D, A + (size_t)b * SEQ * D, (size_t)SEQ * D * 4, hipMemcpyDeviceToDevice, st);
        samp(B, D, D, S_F1);
        hipLaunchKernelGGL(nv::k_postres, dim3(NB * SEQ), dim3(256), 0, st, out, ctxb, out, ctxb, B, post_gain + 3 * D, Ml, 5, 0, 1);
        hipLaunchKernelGGL(dk_sample_stream, dim3(NSAMP), dim3(256), 0, st, out, ctxb, slot(S_OUT));
    }
    hipLaunchKernelGGL(dk_save_bf16, dim3(cdiv((size_t)NB * SEQ * D, 256)), dim3(256), 0, st, out, dbg_final, (size_t)NB * SEQ * D);

    (void)hipMemsetAsync((char*)d_ws + WS_CTL, 0, CTL_ZERO_BYTES, st);
    float* err = (float*)(wsb + WS_CTL) + CW_DBG; int* code = (int*)(wsb + WS_CTL) + CW_DBG + 512;
    int nid = 0;
    auto cmp = [&](const void* fast, int dtype, int ldf, int rowmode, int s, int ncols, int xform) {
        hipLaunchKernelGGL(dk_cmp, dim3(1), dim3(1024), 0, st, fast, (const void*)(wsb + WS_CTXB), dtype, ldf, rowmode, (const float*)slot(s), ncols, xform, err, nid); ++nid; };
    unsigned char* aA = wsb + WS_A; unsigned char* aB = wsb + WS_B;
    for (int p = 0; p < MK_NPHASE; ++p) {
        a.ph_lo = p; a.ph_hi = p + 1;
        hipLaunchKernelGGL(mk_fwd, dim3(grid), dim3(NWAVES * 64), LDS_BYTES, st, a);
        switch (p) {
        case 0: hipLaunchKernelGGL(dk_cmp_flat, dim3(1), dim3(1024), 0, st, (const float*)(wsb + WS_MOD), (const float*)slot(S_MOD), 2 * 5 * NMOD, err, nid); ++nid; break;
        case 1: cmp(aB + B_H0, 0, D, 0, S_H0, D, 0); break;
        case 2: cmp(aA + A_GX, 0, D, 0, S_CL0, D, 1); cmp(aA + A_XL, 0, D, 0, S_CL1, D, 0); cmp(aA + A_Q, 0, 512, 0, S_Q, 512, 0); cmp(aA + A_K, 0, 512, 0, S_K, 512, 0);
                cmp(aA + A_V, 0, D, 0, S_V, D, 0); cmp(aA + A_SG, 0, D, 0, S_CL5, D, 2); cmp(aA + A_ALR, 1, 32, 0, S_ALR, 32, 0); break;
                case 5: cmp(aB + B_Y, 0, 2 * D, 4, S_Y0, D, 0);
                hipLaunchKernelGGL(dk_cmp, dim3(1), dim3(1024), 0, st, (const void*)(aB + B_Y + (size_t)D * 2), (const void*)nullptr, 0, 2 * D, 3, (const float*)slot(S_Y0), D, 0, err, nid); ++nid; break;
        case 6: cmp(aA + A_O, 0, D, 0, S_O0, D, 0); break;
        case 7: cmp(d_out, 2, D, 2, S_X1, D, 0); break;
        case 8: break;
        case 9: break;
        case 10: break;
        case 11: cmp(d_out, 2, D, 2, S_X2, D, 0); cmp(aB + B_H1, 0, D, 1, S_H1, D, 0); break;
        case 12: cmp(aA + A_Q1, 0, D, 1, S_Q1, D, 0); cmp(aA + A_ZF, 1, D, 1, S_ZF, D, 0); cmp(aA + A_ZB, 1, D, 1, S_ZB, D, 0); cmp(aA + A_V1, 0, D, 1, S_V1, D, 0); cmp(aA + A_SG1, 0, D, 1, S_CL4, D, 2); break;
        case 15: hipLaunchKernelGGL(dk_cmp, dim3(1), dim3(1024), 0, st, (const void*)(aB + B_Y1), (const void*)nullptr, 0, D, 5, (const float*)slot(S_Y1), D, 0, err, nid); ++nid; break;
        case 16: hipLaunchKernelGGL(dk_cmp, dim3(1), dim3(1024), 0, st, (const void*)(aA + A_O), (const void*)nullptr, 0, D, 5, (const float*)slot(S_O1), D, 0, err, nid); ++nid; break;
        case 17: hipLaunchKernelGGL(dk_cmp, dim3(1), dim3(1024), 0, st, (const void*)d_out, (const void*)(wsb + WS_CTXB), 2, D, 6, (const float*)slot(S_X3), D, 0, err, nid); ++nid;
                 break;
        case 21: hipLaunchKernelGGL(dk_cmp, dim3(1), dim3(1024), 0, st, (const void*)d_out, (const void*)(wsb + WS_CTXB), 2, D, 6, (const float*)slot(S_OUT), D, 0, err, nid); ++nid; break;

        default: break;
        }
    }
    hipLaunchKernelGGL(dk_verdict, dim3(1), dim3(64), 0, st, err, nid, MK_DEBUG_THR, code);
    hipLaunchKernelGGL(dk_emit, dim3(cdiv((size_t)NB * SEQ * D, 256)), dim3(256), 0, st, code, dbg_final, out, (size_t)NB * SEQ * D, MK_DEBUG_FULL);
}

#endif

extern "C" void kernel_launch(void* const* d_in, const int* in_sizes, int n_in, void* d_out, int out_size, void* d_ws, size_t ws_size, hipStream_t stream) {
    static int grid = 0;
    if (grid == 0) {
        if (n_in != 30 || out_size != NB * SEQ * D || ws_size < WS_END_PROD) { fprintf(stderr, "kernel_launch: bad sizes (n_in %d out %d ws %zu < %zu)\n", n_in, out_size, ws_size, (size_t)WS_END_PROD); grid = -1; return; }
        int dev = 0, cus = 0;
        if (hipGetDevice(&dev) != hipSuccess || hipDeviceGetAttribute(&cus, hipDeviceAttributeMultiprocessorCount, dev) != hipSuccess) { grid = -1; return; }
        if (hipFuncSetAttribute((const void*)mk_fwd, hipFuncAttributeMaxDynamicSharedMemorySize, LDS_BYTES) != hipSuccess) { fprintf(stderr, "kernel_launch: hipFuncSetAttribute failed\n"); grid = -1; return; }
        int per_cu = 0;
        if (hipOccupancyMaxActiveBlocksPerMultiprocessor(&per_cu, (const void*)mk_fwd, NWAVES * 64, LDS_BYTES) != hipSuccess || per_cu < 1) { fprintf(stderr, "kernel_launch: occupancy query says %d blocks/CU\n", per_cu); }
        (void)hipGetLastError();
        grid = cus;
    }
    if (grid < 0) return;
    Args a{};
    for (int i = 0; i < 30; ++i) a.in[i] = (const float*)d_in[i];
    a.out = (float*)d_out; a.ws = (unsigned char*)d_ws;
#if MK_DEBUG
    run_debug(a, d_in, d_out, d_ws, ws_size, stream, grid);
#else
    (void)hipMemsetAsync((char*)d_ws + WS_CTL, 0, CTL_ZERO_BYTES, stream);
    { const int pre[] = {MK_PRE -1};
      int npre = 0; for (int i = 0; pre[i] >= 0; ++i) { a.ph_lo = pre[i]; a.ph_hi = pre[i] + 1; a.abl = MK_ABL; hipLaunchKernelGGL(mk_fwd, dim3(grid), dim3(NWAVES * 64), LDS_BYTES, stream, a); ++npre; }
      a.abl = 0;
      if (npre) (void)hipMemsetAsync((char*)d_ws + WS_CTL, 0, CTL_ZERO_BYTES, stream); }
    a.ph_lo = 0; a.ph_hi = MK_NPHASE;
    hipLaunchKernelGGL(mk_fwd, dim3(grid), dim3(NWAVES * 64), LDS_BYTES, stream, a);
    { const int extra[] = {MK_EXTRA -1};
      for (int i = 0; extra[i] >= 0; ++i) { a.ph_lo = extra[i]; a.ph_hi = extra[i] + 1; a.abl = MK_ABL; hipLaunchKernelGGL(mk_fwd, dim3(grid), dim3(NWAVES * 64), LDS_BYTES, stream, a); } }
#endif
}
```

```cpp
#define MK_DEBUG 0
#define MK_NPHASE 22
#define MK_DEBUG_FULL 1
#define MK_DEBUG_THR 1e-3f
#define MK_EXTRA
#define MK_PRE
#define MK_ABL 0
#define MK_XBAR 0
#include <hip/hip_runtime.h>
#include <cstdio>
#include <cstdint>

constexpr int D = 1024, NB = 4, SEQ = 4096, CTX = 256, T = SEQ + CTX  , R = NB * T  ;
constexpr int NE = 64, TOPK = 8, FF = 256, NMOD = 6 * D;
constexpr int ABC = 5152, CC = 5120;
constexpr int NCH = T / 64;
constexpr float EPS = 1e-6f;

#define GAS __attribute__((address_space(1)))
#define LAS __attribute__((address_space(3)))
typedef unsigned short bf16;
typedef unsigned short f16b;
typedef unsigned v4u __attribute__((ext_vector_type(4)));
typedef unsigned v2u __attribute__((ext_vector_type(2)));
typedef float f32x4 __attribute__((ext_vector_type(4)));
typedef float f32x2 __attribute__((ext_vector_type(2)));
typedef float f32x16 __attribute__((ext_vector_type(16)));
typedef short bf16x8 __attribute__((ext_vector_type(8)));
typedef _Float16 h2_t __attribute__((ext_vector_type(2)));

typedef __bf16 bf2_t __attribute__((ext_vector_type(2)));
__device__ __forceinline__ unsigned pk2(float lo, float hi) { const f32x2 v = {lo, hi}; return __builtin_bit_cast(unsigned, __builtin_convertvector(v, bf2_t)); }
__device__ __forceinline__ unsigned f2bf(float f) { return pk2(f, f) & 0xffffu; }
__device__ __forceinline__ float bf2f(unsigned b) { return __builtin_bit_cast(float, b << 16); }
__device__ __forceinline__ unsigned cvt_pk_bf16(float lo, float hi) { return pk2(lo, hi); }
__device__ __forceinline__ unsigned hwpk2(float lo, float hi) { return pk2(lo, hi); }
__device__ __forceinline__ unsigned short hwbf(float v) { return (unsigned short)pk2(v, v); }
__device__ __forceinline__ float clamp448(float v) { return __builtin_amdgcn_fmed3f(v, -448.f, 448.f); }
__device__ __forceinline__ unsigned pk4f8(float a, float b, float c, float d) { int w = __builtin_amdgcn_cvt_pk_fp8_f32(clamp448(a), clamp448(b), 0, false); w = __builtin_amdgcn_cvt_pk_fp8_f32(clamp448(c), clamp448(d), w, true); return (unsigned)w; }
__device__ __forceinline__ unsigned pk2h(float lo, float hi) { h2_t v; v.x = (_Float16)lo; v.y = (_Float16)hi; return __builtin_bit_cast(unsigned, v); }
__device__ __forceinline__ float h2f(unsigned short h) { return (float)__builtin_bit_cast(_Float16, h); }
__device__ __forceinline__ float bflo(unsigned w) { return __builtin_bit_cast(float, w << 16); }
__device__ __forceinline__ float bfhi(unsigned w) { return __builtin_bit_cast(float, w & 0xffff0000u); }
__device__ __forceinline__ float fexp(float x) { return __builtin_amdgcn_exp2f(x * 1.4426950408889634f); }
__device__ __forceinline__ float frcp(float x) { return __builtin_amdgcn_rcpf(x); }
__device__ __forceinline__ float fsigm(float x) { return frcp(1.f + fexp(-x)); }
__device__ __forceinline__ float fsilu(float x) { return x * frcp(1.f + fexp(-x)); }
__device__ __forceinline__ float fgelu(float x) { const float u = 1.5957691216057308f * (x + 0.044715f * x * x * x); return x * frcp(1.f + fexp(-u)); }
#define LDS_WAIT() asm volatile("s_waitcnt lgkmcnt(0)" ::: "memory")
#define VM_WAIT() asm volatile("s_waitcnt vmcnt(0)" ::: "memory")

__device__ __forceinline__ const float* row_src(const float* xl, const float* xc, int row) {
    const int b = row / T, s = row % T;
    return s < CTX ? xc + ((size_t)b * CTX + s) * D : xl + ((size_t)b * SEQ + (s - CTX)) * D;
}
__device__ __forceinline__ float* row_dst(float* xl, float* xc, int row) {
    const int b = row / T, s = row % T;
    return s < CTX ? xc + ((size_t)b * CTX + s) * D : xl + ((size_t)b * SEQ + (s - CTX)) * D;
}
__device__ __forceinline__ int scan_pos(int i, int rev, int perm) {
    int p;
    if (!rev) p = i; else p = (i < CTX) ? (CTX - 1 - i) : (CTX + (SEQ - 1 - (i - CTX)));
    if (p < CTX || !perm) return p;
    const int q = p - CTX, c = q >> 6, r = q & 63;
    return CTX + r * 64 + c;
}
__device__ __forceinline__ float wave_sum(float v) {
#pragma unroll
    for (int o = 32; o >= 1; o >>= 1) v += __shfl_xor(v, o);
    return v;
}
__device__ __forceinline__ float sigm(float x) { return 1.f / (1.f + expf(-x)); }
__device__ __forceinline__ float siluf(float x) { return x / (1.f + expf(-x)); }
__device__ __forceinline__ float logsigm(float x) { return fminf(x, 0.f) - log1pf(expf(-fabsf(x))); }
__device__ __forceinline__ float gelu_tanh(float x) { return 0.5f * x * (1.f + tanhf(0.7978845608028654f * (x + 0.044715f * x * x * x))); }

#if MK_DEBUG
namespace nv {
__global__ void k_mod(const float* c, const float* cctx, const float* mod_w, const float* mod_b, float* M) {
    const int n = blockIdx.x * 256 + threadIdx.x, r = blockIdx.y, l = blockIdx.z;
    const float* v = r < 4 ? c + r * D : cctx;
    __shared__ float sv[D];
    for (int k = threadIdx.x; k < D; k += 256) sv[k] = siluf(v[k]);
    __syncthreads();
    const float* W = mod_w + (size_t)l * D * NMOD;
    float acc = 0.f;
    for (int k = 0; k < D; ++k) acc += sv[k] * W[(size_t)k * NMOD + n];
    M[(size_t)(l * 5 + r) * NMOD + n] = acc + mod_b[l * NMOD + n];
}
__device__ __forceinline__ float block_sum256(float v, float* red) {
    v = wave_sum(v);
    if ((threadIdx.x & 63) == 0) red[threadIdx.x >> 6] = v;
    __syncthreads();
    const float t = red[0] + red[1] + red[2] + red[3];
    __syncthreads();
    return t;
}
__global__ void k_prenorm(const float* xl, const float* xc, const float* gain, const float* Ml, int shift_i, int scale_i, float* H, int row0) {
    __shared__ float red[4];
    const int row = row0 + blockIdx.x, b = row / T, s = row % T;
    const float* src = row_src(xl, xc, row);
    const float* m = Ml + (size_t)(s < CTX ? 4 : b) * NMOD;
    float v[4], ss = 0.f;
#pragma unroll
    for (int i = 0; i < 4; ++i) { v[i] = src[threadIdx.x + 256 * i]; ss += v[i] * v[i]; }
    const float rstd = rsqrtf(block_sum256(ss, red) * (1.f / D) + EPS);
#pragma unroll
    for (int i = 0; i < 4; ++i) { const int c = threadIdx.x + 256 * i;
        H[(size_t)row * D + c] = v[i] * rstd * gain[c] * (1.f + m[scale_i * D + c]) + m[shift_i * D + c]; }
}
__global__ void k_postres(const float* sl, const float* sc, float* dl, float* dc, const float* O, const float* pgain, const float* Ml, int gate_i, int row0, int lat_only) {
    __shared__ float red[4];
    int row = row0 + blockIdx.x;
    if (lat_only) { const int b = blockIdx.x / SEQ, t = blockIdx.x % SEQ; row = b * T + CTX + t; }
    const int b = row / T, s = row % T;
    const float* src = row_src(sl, sc, row); float* dst = row_dst(dl, dc, row);
    const float* m = Ml + (size_t)(s < CTX ? 4 : b) * NMOD;
    float v[4], ss = 0.f;
#pragma unroll
    for (int i = 0; i < 4; ++i) { v[i] = O[(size_t)row * D + threadIdx.x + 256 * i]; ss += v[i] * v[i]; }
    const float rstd = rsqrtf(block_sum256(ss, red) * (1.f / D) + EPS);
#pragma unroll
    for (int i = 0; i < 4; ++i) { const int c = threadIdx.x + 256 * i;
        dst[c] = src[c] + m[gate_i * D + c] * (v[i] * rstd * pgain[c]); }
}
__global__ void k_gemm(const float* A, int lda, const float* B, int ldb, float* C, int ldc, int M, int N, int K) {
    __shared__ float As[16][68], Bs[16][68];
    const int tid = threadIdx.x, tx = tid & 15, ty = tid >> 4, m0 = blockIdx.y * 64, n0 = blockIdx.x * 64;
    float acc[4][4];
#pragma unroll
    for (int i = 0; i < 4; ++i)
#pragma unroll
        for (int j = 0; j < 4; ++j) acc[i][j] = 0.f;
    for (int k0 = 0; k0 < K; k0 += 16) {
#pragma unroll
        for (int i = 0; i < 4; ++i) {
            const int idx = tid + 256 * i;
            { const int r = idx >> 4, kk = idx & 15; As[kk][r] = (m0 + r < M) ? A[(size_t)(m0 + r) * lda + k0 + kk] : 0.f; }
            { const int kk = idx >> 6, cc = idx & 63; Bs[kk][cc] = (n0 + cc < N) ? B[(size_t)(k0 + kk) * ldb + n0 + cc] : 0.f; }
        }
        __syncthreads();
#pragma unroll
        for (int kk = 0; kk < 16; ++kk) {
            float a[4], b[4];
#pragma unroll
            for (int i = 0; i < 4; ++i) { a[i] = As[kk][ty * 4 + i]; b[i] = Bs[kk][tx * 4 + i]; }
#pragma unroll
            for (int i = 0; i < 4; ++i)
#pragma unroll
                for (int j = 0; j < 4; ++j) acc[i][j] += a[i] * b[j];
        }
        __syncthreads();
    }
#pragma unroll
    for (int i = 0; i < 4; ++i)
#pragma unroll
        for (int j = 0; j < 4; ++j) { const int m = m0 + ty * 4 + i, n = n0 + tx * 4 + j; if (m < M && n < N) C[(size_t)m * ldc + n] = acc[i][j]; }
}
__global__ void k_conv(const float* X, const float* w, const float* bias, float* Y) {
    const size_t i = (size_t)blockIdx.x * 256 + threadIdx.x; if (i >= (size_t)R * D) return;
    const int row = (int)(i / D), c = (int)(i % D), b = row / T, s = row % T;
    const int lo = s < CTX ? 0 : CTX, hi = s < CTX ? CTX : T;
    float acc = bias[c];
#pragma unroll
    for (int j = 0; j < 4; ++j) { const int ss = s + j - 2; if (ss >= lo && ss < hi) acc += w[j * D + c] * X[((size_t)b * T + ss) * D + c]; }
    Y[i] = acc;
}
__global__ void k_lru_gate(float* RA, float* RI, const float* conv, const float* ba, const float* bi, const float* lam) {
    const size_t i = (size_t)blockIdx.x * 256 + threadIdx.x; if (i >= (size_t)R * D) return;
    const int c = (int)(i % D);
    const float r = sigm(RA[i] + ba[c]), g = sigm(RI[i] + bi[c]);
    const float log_a = -8.f * r * log1pf(expf(-lam[c]));
    RA[i] = expf(log_a); RI[i] = sqrtf(-expm1f(2.f * log_a)) * (g * conv[i]);
}
__global__ void k_lru_scan(const float* Aa, const float* U, float* rec, int rev, int accumulate) {
    const int g = blockIdx.x * 256 + threadIdx.x; if (g >= NB * D) return;
    const int b = g / D, c = g % D;
    float h = 0.f;
    for (int i = 0; i < T; ++i) {
        const size_t o = ((size_t)b * T + scan_pos(i, rev, 0)) * D + c;
        h = Aa[o] * h + U[o];
        rec[o] = accumulate ? rec[o] + h : h;
    }
}
__global__ void k_ya(const float* G, const float* rec, float* Y, int ldy) {
    const size_t i = (size_t)blockIdx.x * 256 + threadIdx.x; if (i >= (size_t)R * D) return;
    const int row = (int)(i / D), c = (int)(i % D);
    Y[(size_t)row * ldy + c] = gelu_tanh(G[i]) * rec[i];
}
__global__ void k_scale(float* X, size_t n, float s) { const size_t i = (size_t)blockIdx.x * 256 + threadIdx.x; if (i < n) X[i] *= s; }
__global__ void k_gla_gate(float* G, const float* bias, int ncol) {
    const size_t i = (size_t)blockIdx.x * 256 + threadIdx.x; if (i >= (size_t)R * ncol) return;
    G[i] = logsigm(G[i] + bias[i % ncol]) * (1.f / 16.f);
}
__global__ void k_hgrn_gate(const float* Z, int ldz, const float* lbl, float* LG, float* KK) {
    const size_t i = (size_t)blockIdx.x * 256 + threadIdx.x; if (i >= (size_t)R * D) return;
    const int row = (int)(i / D), c = (int)(i % D);
    const float l0 = lbl[c], l1 = lbl[D + c], mx = fmaxf(l0, l1), e0 = expf(l0 - mx), e1 = expf(l1 - mx), lb = e1 / (e0 + e1);
    const float z = Z[(size_t)row * ldz + c];
    const float f = lb + (1.f - lb) * sigm(z);
    LG[i] = logf(f); KK[i] = (1.f - lb) * sigm(-z);
}
template <int DVH> __global__ void __launch_bounds__(1024) k_gla_scan(const float* q, int ldq, const float* k, int ldk, const float* v, int ldv, const float* g, int ldg, float* o, int ldo, int rev, int perm, int accumulate) {
    __shared__ float red[16];
    const int tid = threadIdx.x, d = tid & 127, el = tid >> 7, e = blockIdx.x * 8 + el, h = blockIdx.y, b = blockIdx.z, wv = tid >> 6;
    float S = 0.f;
    size_t row = (size_t)b * T + scan_pos(0, rev, perm);
    float gg = g[row * ldg + h * 128 + d], kk = k[row * ldk + h * 128 + d], vv = v[row * ldv + h * DVH + e], qq = q[row * ldq + h * 128 + d];
    for (int i = 0; i < T; ++i) {
        const size_t crow = row; const float cg = gg, ck = kk, cv = vv, cq = qq;
        if (i + 1 < T) { row = (size_t)b * T + scan_pos(i + 1, rev, perm);
            gg = g[row * ldg + h * 128 + d]; kk = k[row * ldk + h * 128 + d]; vv = v[row * ldv + h * DVH + e]; qq = q[row * ldq + h * 128 + d]; }
        S = expf(cg) * S + ck * cv;
        const float p = wave_sum(cq * S);
        if ((tid & 63) == 0) red[wv] = p;
        __syncthreads();
        if (d == 0) { const float t = red[2 * el] + red[2 * el + 1]; float* op = o + crow * ldo + h * DVH + e; *op = accumulate ? *op + t : t; }
        __syncthreads();
    }
}
template <int DVH> __global__ void k_yb(const float* att, const float* gate, int ldg, float* Y, int ldy, int nheads) {
    const int wid = (blockIdx.x * 256 + threadIdx.x) >> 6, lane = threadIdx.x & 63;
    if (wid >= R * nheads) return;
    const int row = wid / nheads, h = wid % nheads;
    float v[DVH / 64], ss = 0.f;
#pragma unroll
    for (int i = 0; i < DVH / 64; ++i) { v[i] = att[(size_t)row * (nheads * DVH) + h * DVH + lane + 64 * i]; ss += v[i] * v[i]; }
    const float rstd = rsqrtf(wave_sum(ss) * (1.f / DVH) + EPS);
#pragma unroll
    for (int i = 0; i < DVH / 64; ++i) { const int c = h * DVH + lane + 64 * i; Y[(size_t)row * ldy + c] = v[i] * rstd * siluf(gate[(size_t)row * ldg + c]); }
}
__global__ void k_route(const float* logits, const float* bias, int ntok, int* tk_e, float* tk_w, int* cnt, int* list) {
    const int t = (blockIdx.x * 256 + threadIdx.x) >> 6, e = threadIdx.x & 63;
    if (t >= ntok) return;
    const float aff = sigm(logits[(size_t)t * NE + e]), bs = aff + bias[e];
    int rk = 0;
#pragma unroll
    for (int j = 0; j < 8; ++j) { const int o = (e & ~7) + j; const float x = __shfl(bs, o); rk += (x > bs || (x == bs && o < e)) ? 1 : 0; }
    float gs = rk < 2 ? bs : 0.f;
    gs += __shfl_xor(gs, 1); gs += __shfl_xor(gs, 2); gs += __shfl_xor(gs, 4);
    int grk = 0; const int gi = e >> 3;
#pragma unroll
    for (int j = 0; j < 8; ++j) { const float x = __shfl(gs, j * 8); grk += (x > gs || (x == gs && j < gi)) ? 1 : 0; }
    const bool keep = grk < 4;
    const float mv = keep ? bs : -INFINITY;
    int erk = 0;
    for (int j = 0; j < 64; ++j) { const float x = __shfl(mv, j); erk += (x > mv || (x == mv && j < e)) ? 1 : 0; }
    const bool sel = keep && erk < TOPK;
    const float ssum = wave_sum(sel ? aff : 0.f);
    if (sel) {
        tk_e[(size_t)t * TOPK + erk] = e; tk_w[(size_t)t * TOPK + erk] = 2.5f * aff / ssum;
        const int pos = atomicAdd(&cnt[e], 1);
        list[(size_t)e * R + pos] = t * TOPK + erk;
    }
}
__global__ void k_expert(const float* H, int tok_row0  , int ntok, const float* Wg, const float* Wu, const float* Wd, const int* cnt, const int* list, const float* tk_w, int e, float* F, int assign) {
    __shared__ float hs[8][D];
    __shared__ float as[8][FF];
    __shared__ int tok[8]; __shared__ float wt[8];
    const int tid = threadIdx.x, n_rows = (e < NE) ? cnt[e] : ntok, p0 = blockIdx.x * 8;
    if (p0 >= n_rows) return;
    if (tid < 8) { const int p = p0 + tid; int tk = -1; float w = 0.f;
        if (p < n_rows) { if (e < NE) { const int slot = list[(size_t)e * R + p]; tk = slot / TOPK; w = tk_w[slot]; } else { tk = p; w = 1.f; } }
        tok[tid] = tk; wt[tid] = w; }
    __syncthreads();
#pragma unroll
    for (int r = 0; r < 8; ++r) { const int tk = tok[r];
#pragma unroll
        for (int i = 0; i < 4; ++i) hs[r][tid + 256 * i] = tk >= 0 ? H[(size_t)(tok_row0 + tk) * D + tid + 256 * i] : 0.f; }
    __syncthreads();
    float ag[8], au[8];
#pragma unroll
    for (int r = 0; r < 8; ++r) { ag[r] = 0.f; au[r] = 0.f; }
    for (int k = 0; k < D; ++k) { const float wg = Wg[(size_t)k * FF + tid], wu = Wu[(size_t)k * FF + tid];
#pragma unroll
        for (int r = 0; r < 8; ++r) { const float hv = hs[r][k]; ag[r] += hv * wg; au[r] += hv * wu; } }
#pragma unroll
    for (int r = 0; r < 8; ++r) as[r][tid] = siluf(ag[r]) * au[r];
    __syncthreads();
    float acc[8][4];
#pragma unroll
    for (int r = 0; r < 8; ++r)
#pragma unroll
        for (int c = 0; c < 4; ++c) acc[r][c] = 0.f;
    for (int j = 0; j < FF; ++j) { float w[4];
#pragma unroll
        for (int c = 0; c < 4; ++c) w[c] = Wd[(size_t)j * D + tid + 256 * c];
#pragma unroll
        for (int r = 0; r < 8; ++r) { const float a = as[r][j];
#pragma unroll
            for (int c = 0; c < 4; ++c) acc[r][c] += a * w[c]; } }
#pragma unroll
    for (int r = 0; r < 8; ++r) { const int tk = tok[r]; if (tk < 0) continue; const float w = wt[r];
#pragma unroll
        for (int c = 0; c < 4; ++c) { float* fp = F + (size_t)tk * D + tid + 256 * c; *fp = assign ? w * acc[r][c] : *fp + w * acc[r][c]; } }
}
}

#endif

namespace pg8 {
constexpr int BM = 256, BK = 64, HALF = 128, HTB = HALF * BK * 2  , STAGE_BYTES = 8 * HTB, NXCD = 8, WGM = 8;
__device__ __forceinline__ int lds_byte(int r, int c) { const int st = (r >> 4) * 2 + (c >> 5), rr = r & 15, cc = c & 31, ob = rr * 64 + cc * 2; return st * 1024 + (ob ^ (((ob >> 9) & 1) << 5)); }
__device__ __forceinline__ void stage_rc(int b, int& R_, int& C_) { const int st = b / 1024, sb = b % 1024, swz = sb ^ (((sb >> 9) & 1) << 5); R_ = (st >> 1) * 16 + swz / 64; C_ = (st & 1) * 32 + (swz % 64) / 2; }
__device__ __forceinline__ int perm32(int rho) { const int n = rho >> 4, i = rho & 15; return 8 * (i >> 2) + 4 * n + (i & 3); }

struct Unit { int pm, pn, e, arow0; };

__device__ __forceinline__ int xcd_remap(int L, int nU) { const int q = nU / NXCD, r = nU % NXCD, xcd = L % NXCD, off = L / NXCD; return (xcd < r ? xcd * (q + 1) : r * (q + 1) + (xcd - r) * q) + off; }

typedef int v8i __attribute__((ext_vector_type(8)));
typedef int v4i __attribute__((ext_vector_type(4)));
template <class Epi, class Sched, bool F8 = false>
__device__ __forceinline__ void gemm_phase(LAS unsigned char* lds, const int K, const Sched& S, const Epi& E) {
    const int tid = threadIdx.x, wid = __builtin_amdgcn_readfirstlane(tid >> 6), lane = tid & 63, wr = wid >> 2, wc = wid & 3, fr = lane & 15, fq = lane >> 4;
    const int nt = K / BK;
    unsigned voffB[2];
#pragma unroll
    for (int i = 0; i < 2; ++i) { int R_, C_; stage_rc(tid * 16 + i * 8192, R_, C_); const int Rb = (R_ & ~31) + perm32(R_ & 31); voffB[i] = (unsigned)(Rb * K + C_) * 2u; }
    const size_t kstep = (size_t)(BK * 2);
    const size_t hstep = (size_t)HALF * K * 2;
    const unsigned ldsw = (unsigned)wid * 1024u;
    const int aoff = lds_byte(wr * 64 + fr, fq * 8), boff = lds_byte(wc * 32 + fr, fq * 8);
    const int aoff8a = lds_byte(wr * 64 + fr, fq * 16), boff8a = lds_byte(wc * 32 + fr, fq * 16);
#define PG8_SA(b, h) (((b) * 2 + (h)) * HTB)
#define PG8_SB(b, h) ((4 + (b) * 2 + (h)) * HTB)
#define PG8_STAGE(bufoff, gbase, voff) do { _Pragma("unroll") for (int _i = 0; _i < 2; ++_i) \
        __builtin_amdgcn_global_load_lds((const unsigned*)((const char*)(gbase) + (voff)[_i]), (LAS unsigned*)(lds + (bufoff) + ldsw + _i * 8192), 16, 0, 0); } while (0)
#define PG8_LDA(dst, b, h) do { _Pragma("unroll") for (int m = 0; m < 4; ++m) { if constexpr (F8) { const v4i lo_ = *(const LAS v4i*)(lds + PG8_SA(b, h) + aoff8a + m * 2048), hi_ = *(const LAS v4i*)(lds + PG8_SA(b, h) + aoff8a + m * 2048 + 16); \
            dst##8[m] = __builtin_shufflevector(lo_, hi_, 0, 1, 2, 3, 4, 5, 6, 7); } \
        else { _Pragma("unroll") for (int k = 0; k < 2; ++k) dst[m][k] = *(const LAS bf16x8*)(lds + PG8_SA(b, h) + aoff + m * 2048 + k * 1024); } } } while (0)
#define PG8_LDB(dst, b, h) do { _Pragma("unroll") for (int n = 0; n < 2; ++n) { if constexpr (F8) { const v4i lo_ = *(const LAS v4i*)(lds + PG8_SB(b, h) + boff8a + n * 2048), hi_ = *(const LAS v4i*)(lds + PG8_SB(b, h) + boff8a + n * 2048 + 16); \
            dst##8[n] = __builtin_shufflevector(lo_, hi_, 0, 1, 2, 3, 4, 5, 6, 7); } \
        else { _Pragma("unroll") for (int k = 0; k < 2; ++k) dst[n][k] = *(const LAS bf16x8*)(lds + PG8_SB(b, h) + boff + n * 2048 + k * 1024); } } } while (0)
#define PG8_MMA(ai, bj, At, Bt) do { __builtin_amdgcn_s_setprio(1); _Pragma("unroll") for (int m = 0; m < 4; ++m) _Pragma("unroll") for (int n = 0; n < 2; ++n) { \
        if constexpr (F8) acc[ai][bj][m][n] = __builtin_amdgcn_mfma_scale_f32_16x16x128_f8f6f4(Bt##8[n], At##8[m], acc[ai][bj][m][n], 0, 0, 0, 0x7C7C7C7C, 0, 0x7C7C7C7C);     \
        else { _Pragma("unroll") for (int k = 0; k < 2; ++k) acc[ai][bj][m][n] = __builtin_amdgcn_mfma_f32_16x16x32_bf16(Bt[n][k], At[m][k], acc[ai][bj][m][n], 0, 0, 0); } } \
        __builtin_amdgcn_s_setprio(0); } while (0)
#define PG8_WAIT_V(n) asm volatile("s_waitcnt vmcnt(" #n ")" ::: "memory")
#define PG8_WAIT_L(n) asm volatile("s_waitcnt lgkmcnt(" #n ")" ::: "memory")
#define PG8_BAR __builtin_amdgcn_s_barrier()
#define PG8_SCHED __builtin_amdgcn_sched_barrier(0)
    Unit cur, nxt; int ui = 0;
    if (!S.next(0, cur)) return;
    f32x4 acc[2][2][4][2];
#pragma unroll
    for (int a = 0; a < 2; ++a)
#pragma unroll
        for (int b = 0; b < 2; ++b)
#pragma unroll
            for (int m = 0; m < 4; ++m)
#pragma unroll
                for (int n = 0; n < 2; ++n) acc[a][b][m][n] = (f32x4){0.f, 0.f, 0.f, 0.f};
    bf16x8 At[4][2], B0[2][2], B1[2][2];
    v8i At8[4], B08[2], B18[2];
    unsigned vA[2][2], vN[2][2];
    S.a_offs(cur, vA, tid);
    const char* const Ab = S.a_base();
    const char* cB = S.b_base(cur);
    PG8_STAGE(PG8_SB(0, 0), cB, voffB); PG8_STAGE(PG8_SB(0, 1), cB + hstep, voffB); PG8_STAGE(PG8_SA(0, 0), Ab, vA[0]); PG8_STAGE(PG8_SA(0, 1), Ab, vA[1]);
    if (wr == 1) PG8_BAR;
    PG8_WAIT_V(2); PG8_BAR;
    PG8_STAGE(PG8_SB(1, 0), cB + kstep, voffB); PG8_STAGE(PG8_SA(1, 0), Ab + kstep, vA[0]); PG8_STAGE(PG8_SB(1, 1), cB + hstep + kstep, voffB);
    PG8_WAIT_V(6); PG8_BAR;
    for (;;) {
        const bool has_next = S.next(ui + 1, nxt);
        const char* nB = has_next ? S.b_base(nxt) : cB;
        if (has_next) S.a_offs(nxt, vN, tid);
        else { vN[0][0] = vA[0][0]; vN[0][1] = vA[0][1]; vN[1][0] = vA[1][0]; vN[1][1] = vA[1][1]; }
        for (int t = 0; t < nt; t += 2) {
            const bool last = (t == nt - 2);
            const char* a1 = Ab + (size_t)(t + 1) * kstep;
            PG8_LDB(B0, 0, 0); PG8_LDB(B1, 0, 1); PG8_SCHED; PG8_LDA(At, 0, 0); PG8_STAGE(PG8_SA(1, 1), a1, vA[1]);
            PG8_WAIT_V(8); PG8_WAIT_L(0); PG8_BAR; PG8_MMA(0, 0, At, B0); PG8_MMA(0, 1, At, B1); PG8_BAR; PG8_SCHED;
            const char* a2; const char* b2;
            if (last) { vA[0][0] = vN[0][0]; vA[0][1] = vN[0][1]; vA[1][0] = vN[1][0]; vA[1][1] = vN[1][1]; a2 = Ab; b2 = nB; }
            else { a2 = Ab + (size_t)(t + 2) * kstep; b2 = cB + (size_t)(t + 2) * kstep; }
            const char* a3 = a2 + kstep; const char* b3 = b2 + kstep;
            PG8_LDA(At, 0, 1); PG8_STAGE(PG8_SB(0, 0), b2, voffB); PG8_STAGE(PG8_SB(0, 1), b2 + hstep, voffB); PG8_STAGE(PG8_SA(0, 0), a2, vA[0]);
            PG8_WAIT_V(8); PG8_WAIT_L(0); PG8_BAR; PG8_MMA(1, 0, At, B0); PG8_MMA(1, 1, At, B1); PG8_BAR; PG8_SCHED;
            PG8_LDB(B0, 1, 0); PG8_LDB(B1, 1, 1); PG8_SCHED; PG8_LDA(At, 1, 0); PG8_STAGE(PG8_SA(0, 1), a2, vA[1]);
            PG8_WAIT_V(8); PG8_WAIT_L(0); PG8_BAR; PG8_MMA(0, 0, At, B0); PG8_MMA(0, 1, At, B1); PG8_BAR; PG8_SCHED;
            PG8_LDA(At, 1, 1); PG8_STAGE(PG8_SB(1, 0), b3, voffB); PG8_STAGE(PG8_SB(1, 1), b3 + hstep, voffB); PG8_STAGE(PG8_SA(1, 0), a3, vA[0]);
            PG8_WAIT_V(8); PG8_WAIT_L(0); PG8_BAR; PG8_MMA(1, 0, At, B0); PG8_MMA(1, 1, At, B1); PG8_BAR; PG8_SCHED;
        }
        if (wr == 0) PG8_BAR;
        E(acc, cur, wr, wc, fr, fq);
        if (!has_next) break;
#pragma unroll
        for (int a = 0; a < 2; ++a)
#pragma unroll
            for (int b = 0; b < 2; ++b)
#pragma unroll
                for (int m = 0; m < 4; ++m)
#pragma unroll
                    for (int n = 0; n < 2; ++n) acc[a][b][m][n] = (f32x4){0.f, 0.f, 0.f, 0.f};
        cur = nxt; cB = nB; ++ui;
        if (wr == 1) PG8_BAR;
    }
    PG8_WAIT_V(0);
    PG8_BAR;
#undef PG8_SA
#undef PG8_SB
#undef PG8_STAGE
#undef PG8_LDA
#undef PG8_LDB
#undef PG8_MMA
#undef PG8_WAIT_V
#undef PG8_WAIT_L
#undef PG8_BAR
#undef PG8_SCHED
}
}

constexpr size_t RD2 = (size_t)R * D * 2;
constexpr size_t WS_CTL = 0, CTL_ZERO_BYTES = 1048576;
constexpr size_t WS_MOD = WS_CTL + CTL_ZERO_BYTES;
constexpr size_t WS_CTXB = WS_MOD + 262144;
constexpr size_t WS_TKE = WS_CTXB + (size_t)NB * CTX * D * 4;
constexpr size_t WS_TKP = WS_TKE + (size_t)R * 8 * 4, WS_TKW = WS_TKP + (size_t)R * 8 * 4;
constexpr size_t WS_LIST = WS_TKW + (size_t)R * 8 * 4;
constexpr size_t WS_LRU = WS_LIST + (size_t)NE * R * 4;
constexpr size_t WS_W_IN0 = WS_LRU + (size_t)2 * NB * NCH * D * 2 * 4;
constexpr int NIN0 = 5376;
constexpr size_t WS_W_OUT0 = WS_W_IN0 + (size_t)NIN0 * D * 2;
constexpr size_t WS_W_IN1 = WS_W_OUT0 + (size_t)D * 2 * D * 2;
constexpr size_t WS_W_OUT1 = WS_W_IN1 + (size_t)CC * D * 2;
constexpr size_t WS_W_LRU = WS_W_OUT1 + (size_t)D * D * 2;
constexpr size_t WS_W_RT = WS_W_LRU + (size_t)2 * 2 * 8 * 128 * 128 * 2;
constexpr size_t WS_W2T = WS_W_RT + (size_t)2 * 2 * NE * D * 2;
constexpr size_t WS_B = WS_W2T + (size_t)65 * D * FF * 2;
constexpr int MAXTILES = 676;
constexpr size_t AREA_B_BYTES = 89128960;
constexpr size_t WS_A = WS_B + AREA_B_BYTES;
constexpr size_t AREA_A_BYTES = (size_t)MAXTILES * 256 * D * 2;
constexpr size_t WS_DBG = WS_A + AREA_A_BYTES;
constexpr size_t WS_W1T1 = WS_DBG, WS_W2T1 = WS_W1T1 + (size_t)65 * 512 * D;
constexpr size_t WS_END_W = WS_W2T1 + (size_t)65 * D * FF;
constexpr size_t LRU_PIECE = (size_t)34 * 64 * D * 2;
constexpr size_t WS_END_PROD = MK_DEBUG ? WS_DBG : WS_END_W + 2 * LRU_PIECE;
static_assert(AREA_B_BYTES >= (size_t)MAXTILES * 256 * FF * 2 && AREA_B_BYTES >= 2 * RD2, "AREA_B");
constexpr size_t A_GX = 0, A_XL = RD2, A_Q = 2 * RD2, A_K = 2 * RD2 + RD2 / 2, A_V = 3 * RD2, A_SG = 4 * RD2, A_ALR = 5 * RD2, A_KV = 5 * RD2 + (size_t)R * 32 * 2;
constexpr size_t KV_BYTES = (size_t)32 * NCH * 32768 * 2;
static_assert(A_KV + KV_BYTES <= AREA_A_BYTES, "mixer overlay");
constexpr size_t A_DEC_ = A_KV + KV_BYTES, A_FREE = A_DEC_ + (size_t)2 * 64 * NCH * 128 * 4;
static_assert(A_FREE + 6 * LRU_PIECE <= AREA_A_BYTES && 2 * RD2 + 4 * LRU_PIECE <= AREA_B_BYTES && 3 * LRU_PIECE <= (size_t)65 * D * FF && LRU_PIECE <= (size_t)NE * R * 4, "lru pieces");
__device__ __forceinline__ size_t lru_piece(int i) {
    return i < 6 ? WS_A + A_FREE + (size_t)i * LRU_PIECE : i < 10 ? WS_B + 2 * RD2 + (size_t)(i - 6) * LRU_PIECE : i < 13 ? WS_W2T + (size_t)(i - 10) * LRU_PIECE : i < 14 ? WS_LIST : WS_END_W + (size_t)(i - 14) * LRU_PIECE;
}
constexpr size_t A_Q1 = 0, A_ZF = RD2, A_ZB = 2 * RD2, A_V1 = 3 * RD2, A_SG1 = 4 * RD2;
constexpr size_t A_W1T = 0;
constexpr size_t A_H = (size_t)65 * 512 * D * 2, A_HL = A_H + RD2, A_O = 4 * RD2;
constexpr size_t A_H8 = 5 * RD2;
static_assert(A_HL + RD2 <= A_O, "moe overlay");
constexpr size_t B_H0 = 0, B_Y = 0, B_ACT = 0, B_H1 = 0, B_Y1 = RD2;
constexpr int CW_TMO = 0, CW_CODE = 1, CW_BAR = 4096, CW_CNT = 8192  , CW_DBG = 16384;

constexpr int RING_BYTES = 131072;
constexpr int MISC_OFF = 157696;
constexpr int LDS_BYTES = 157696 + 128;
constexpr int NWAVES = 8;

typedef GAS unsigned gu32;
#define RLX_AGENT __ATOMIC_RELAXED, __HIP_MEMORY_SCOPE_AGENT

#define XB_TMO      128
#define XB_XCNT(j)  (256  + 64 * (j))
#define XB_XSUB(j)  (1280 + 64 * (j))
#define XB_XGEN(j)  (2304 + 64 * (j))
#define XB_TOP      3328
#define XB_TOPGEN   3392
#define XCD_BAR_WORDS 3456
#define XB_SPIN_CAP (1u << 20)
__device__ __forceinline__ unsigned xb_ld(unsigned* p)              { return __hip_atomic_load(p, __ATOMIC_RELAXED, __HIP_MEMORY_SCOPE_AGENT); }
__device__ __forceinline__ unsigned xb_add(unsigned* p, unsigned v) { return __hip_atomic_fetch_add(p, v, __ATOMIC_RELAXED, __HIP_MEMORY_SCOPE_AGENT); }
__device__ __forceinline__ unsigned xb_xcc_id() { return (unsigned)__builtin_amdgcn_s_getreg((3 << 11) | 20) & 0xFu; }
#define XB_SPIN(cond, bar) do { unsigned _sp = 0; while (cond) { __builtin_amdgcn_s_sleep(1); \
    if ((++_sp & 255u) == 0u) { if (xb_ld(&(bar)[XB_TMO])) break; if (_sp > XB_SPIN_CAP) { atomicAdd(&(bar)[XB_TMO], 1u); break; } } } } while (0)
struct XcdBarrier { unsigned* bar; unsigned x; volatile LAS unsigned* st; };
__device__ __forceinline__ XcdBarrier xcd_barrier_post(unsigned* bar, volatile LAS unsigned* st) {
    XcdBarrier b; b.bar = bar; b.x = xb_xcc_id(); b.st = st;
    if (threadIdx.x == 0) (void)xb_add(&bar[XB_XCNT(b.x)], 1u);
    return b;
}
__device__ __forceinline__ void xcd_barrier_complete(unsigned* bar, unsigned x, unsigned& nloc, unsigned& nx) {
    const unsigned G = gridDim.x * gridDim.y * gridDim.z;
    unsigned sum, cnt, mine, sp = 0u;
    for (;;) {
        sum = 0u; cnt = 0u; mine = 0u;
#pragma unroll
        for (unsigned j = 0; j < 16; ++j) { const unsigned c = xb_ld(&bar[XB_XCNT(j)]); sum += c; cnt += (c > 0u) ? 1u : 0u; mine = (j == x) ? c : mine; }
        if (sum == G) break;
        __builtin_amdgcn_s_sleep(1);
        if ((++sp & 255u) == 0u) { if (xb_ld(&bar[XB_TMO])) break; if (sp > XB_SPIN_CAP) { atomicAdd(&bar[XB_TMO], 1u); break; } }
    }
    nloc = mine > 0u ? mine : 1u; nx = cnt > 0u ? cnt : 1u;
}
__device__ __forceinline__ void xcd_barrier(const XcdBarrier& b) {
    asm volatile("s_waitcnt vmcnt(0)" ::: "memory");
    __syncthreads();
    if (threadIdx.x == 0) {
        unsigned* bar = b.bar;
        __builtin_amdgcn_s_waitcnt(0);
        unsigned nloc = b.st[0], nx = b.st[1];
        if (nloc == 0u) { xcd_barrier_complete(bar, b.x, nloc, nx); b.st[0] = nloc; b.st[1] = nx; }
        const unsigned old = xb_add(&bar[XB_XSUB(b.x)], 1u);
        const unsigned gen = old / nloc;
        if (old + 1u == (gen + 1u) * nloc) {
            __builtin_amdgcn_fence(__ATOMIC_RELEASE, "agent");
            asm volatile("s_waitcnt vmcnt(0)" ::: "memory");
            const unsigned og = xb_add(&bar[XB_TOP], 1u);
            const unsigned tg = og / nx;
            if (og + 1u == (tg + 1u) * nx) xb_add(&bar[XB_TOPGEN], 1u);
            else XB_SPIN(xb_ld(&bar[XB_TOPGEN]) == tg, bar);
            __builtin_amdgcn_fence(__ATOMIC_ACQUIRE, "agent");
            xb_add(&bar[XB_XGEN(b.x)], 1u);
            asm volatile("s_waitcnt vmcnt(0)" ::: "memory");
        } else {
            XB_SPIN(xb_ld(&bar[XB_XGEN(b.x)]) == gen, bar);
            __builtin_amdgcn_fence(__ATOMIC_ACQUIRE, "agent");
            asm volatile("s_waitcnt vmcnt(0)" ::: "memory");
        }
    }
    __syncthreads();
}

struct Args { const float* in[30]; float* out; unsigned char* ws; int ph_lo, ph_hi, abl, pad; };
struct Frame {
    LAS unsigned char* lds;
    volatile LAS unsigned* MISC;
    gu32* ctl;
    int tid, lane, wave, vcu, G;
    unsigned char* ws;
    float* out;
};
enum { I_X = 0, I_C, I_CTX, I_CCTX, I_MODW, I_MODB, I_PREG, I_POSTG, I_ABWIN, I_CONVW, I_CONVB, I_LRUWA, I_LRUBA, I_LRUWI, I_LRUBI, I_LRULAM, I_GLAWA2, I_GLABA, I_ABWOUT,
       I_CWIN, I_LBL, I_CWOUT, I_ROUTER, I_MOEB, I_WG, I_WU, I_WD, I_WSG, I_WSU, I_WSD };

__device__ __forceinline__ int mod_row(int row) { const int b = row / T, s = row - b * T; return s < CTX ? 4 : b; }

__device__ __forceinline__ void transpose_item(const float* Wsrc, int ldw, bf16* WTdst, int ldt, int rs, LAS float* scr, int lane) {
    float wv[32];
#pragma unroll
    for (int i = 0; i < 32; ++i) { const int kk = 2 * i + (lane >> 5); wv[i] = __builtin_nontemporal_load(Wsrc + (size_t)kk * ldw + (lane & 31)); }
#pragma unroll
    for (int i = 0; i < 32; ++i) { const int kk = 2 * i + (lane >> 5); scr[kk * 33 + (lane & 31)] = wv[i]; }
    LDS_WAIT(); asm volatile("" ::: "memory");
    const int c = lane & 7;
#pragma unroll
    for (int j = 0; j < 4; ++j) { const int n = (lane >> 3) + 8 * j; const LAS float* s = scr + (8 * c) * 33 + n;
        v4u o; o.x = hwpk2(s[0 * 33], s[1 * 33]); o.y = hwpk2(s[2 * 33], s[3 * 33]); o.z = hwpk2(s[4 * 33], s[5 * 33]); o.w = hwpk2(s[6 * 33], s[7 * 33]);
        if (rs) *(GAS v4u*)(WTdst + (size_t)((n >> 2) * rs + (n & 3)) * ldt + 8 * c) = o;
        else *(GAS v4u*)(WTdst + (size_t)((((c >> 1) * 2 + (c & 1)) * 32 + n) * 8)) = o; }
    LDS_WAIT(); asm volatile("" ::: "memory");
}
__device__ __forceinline__ void transpose_item8(const float* Wsrc, int ldw, unsigned char* WTdst, int ldt, int rs, LAS float* scr, int lane) {
    float wv[32];
#pragma unroll
    for (int i = 0; i < 32; ++i) { const int kk = 2 * i + (lane >> 5); wv[i] = __builtin_nontemporal_load(Wsrc + (size_t)kk * ldw + (lane & 31)); }
#pragma unroll
    for (int i = 0; i < 32; ++i) { const int kk = 2 * i + (lane >> 5); scr[kk * 33 + (lane & 31)] = wv[i] * 64.f; }
    LDS_WAIT(); asm volatile("" ::: "memory");
    const int c = lane & 7;
#pragma unroll
    for (int j = 0; j < 4; ++j) { const int n = (lane >> 3) + 8 * j; const LAS float* s = scr + (8 * c) * 33 + n;
        v2u o; o.x = pk4f8(s[0 * 33], s[1 * 33], s[2 * 33], s[3 * 33]); o.y = pk4f8(s[4 * 33], s[5 * 33], s[6 * 33], s[7 * 33]);
        *(GAS v2u*)(WTdst + (size_t)((n >> 2) * rs + (n & 3)) * ldt + 8 * c) = o; }
    LDS_WAIT(); asm volatile("" ::: "memory");
}
__device__ __forceinline__ void transpose_matrix8(const float* W, int K, int N, int ldw, unsigned char* WT, int ldt, int rs, LAS float* scr, int lane, int gw, int NGW, int& itbase) {
    const int nblk = N / 32, nitems = (K / 64) * nblk;
    int first = (gw - itbase % NGW + NGW) % NGW;
    for (int it = first; it < nitems; it += NGW) { const int kb = it / nblk, nb = it % nblk;
        transpose_item8(W + (size_t)(64 * kb) * ldw + 32 * nb, ldw, WT + (size_t)(32 * nb / 4 * rs) * ldt + 64 * kb, ldt, rs, scr, lane); }
    itbase += nitems;
}
__device__ __forceinline__ void transpose_matrix(const float* W, int K, int N, int ldw, bf16* WT, int ldt, int rs, LAS float* scr, int lane, int gw, int NGW, int& itbase) {
    const int nblk = N / 32, nitems = (K / 64) * nblk;
    int first = (gw - itbase % NGW + NGW) % NGW;
    for (int it = first; it < nitems; it += NGW) { const int kb = it / nblk, nb = it % nblk;
        if (rs) transpose_item(W + (size_t)(64 * kb) * ldw + 32 * nb, ldw, WT + (size_t)(32 * nb / 4 * rs) * ldt + 64 * kb, ldt, rs, scr, lane);
        else transpose_item(W + (size_t)(64 * kb) * ldw + 32 * nb, ldw, WT + ((size_t)nb * (K / 16) + 4 * kb) * 512, ldt, 0, scr, lane); }
    itbase += nitems;
}

__device__ __forceinline__ void p0_prep(Frame& F, const Args& A) {
    if (F.vcu < 192) {
        LAS float* sv = (LAS float*)F.lds;
        LAS float* red = (LAS float*)(F.lds + 20480);
        for (int i = F.tid; i < 5 * D; i += NWAVES * 64) { const int r = i >> 10, k = i & 1023; const float t = r < 4 ? A.in[I_C][r * D + k] : A.in[I_CCTX][k]; sv[i] = t / (1.f + expf(-t)); }
        __syncthreads();
        const int l = F.vcu / 96, n0 = (F.vcu % 96) * 64;
        const float* W = A.in[I_MODW] + (size_t)l * D * NMOD + n0 + F.lane;
        float acc[5] = {0.f, 0.f, 0.f, 0.f, 0.f};
        const int k0 = F.wave * 128;
#pragma unroll 1
        for (int kk = 0; kk < 128; kk += 32) {
            float w[32];
#pragma unroll
            for (int j = 0; j < 32; ++j) w[j] = __builtin_nontemporal_load(W + (size_t)(k0 + kk + j) * NMOD);
#pragma unroll
            for (int j = 0; j < 32; ++j)
#pragma unroll
                for (int r = 0; r < 5; ++r) acc[r] += sv[r * D + k0 + kk + j] * w[j];
        }
#pragma unroll
        for (int r = 0; r < 5; ++r) red[(F.wave * 5 + r) * 64 + F.lane] = acc[r];
        __syncthreads();
        if (F.tid < 320) { const int r = F.tid >> 6, ln = F.tid & 63; float s = 0.f;
#pragma unroll
            for (int w = 0; w < 8; ++w) s += red[(w * 5 + r) * 64 + ln];
            ((float*)(F.ws + WS_MOD))[(size_t)(l * 5 + r) * NMOD + n0 + ln] = s + A.in[I_MODB][l * NMOD + n0 + ln]; }
        __syncthreads();
    }
    LAS float* scr = (LAS float*)(F.lds + F.wave * 16384);
    const int gw = F.vcu * NWAVES + F.wave, NGW = F.G * NWAVES;
    int itb = 0;
    transpose_matrix(A.in[I_ABWIN], D, ABC, ABC, (bf16*)(F.ws + WS_W_IN0), D, 4, scr, F.lane, gw, NGW, itb);
    transpose_matrix(A.in[I_ABWOUT], 2 * D, D, D, (bf16*)(F.ws + WS_W_OUT0), 2 * D, 4, scr, F.lane, gw, NGW, itb);
    transpose_matrix(A.in[I_CWIN], D, CC, CC, (bf16*)(F.ws + WS_W_IN1), D, 4, scr, F.lane, gw, NGW, itb);
    transpose_matrix(A.in[I_CWOUT], D, D, D, (bf16*)(F.ws + WS_W_OUT1), D, 4, scr, F.lane, gw, NGW, itb);
    for (int mtx = 0; mtx < 32; ++mtx) {
        const int d = mtx >> 4, ai = (mtx >> 3) & 1, h = mtx & 7;
        transpose_matrix(A.in[ai ? I_LRUWI : I_LRUWA] + (size_t)(d * 8 + h) * 16384, 128, 128, 128, (bf16*)(F.ws + WS_W_LRU) + (size_t)mtx * 16384, 128, 0, scr, F.lane, gw, NGW, itb);
    }
    for (int i = F.vcu * NWAVES * 64 + F.tid; i < D; i += F.G * NWAVES * 64) { const float l0 = A.in[I_LBL][i], l1 = A.in[I_LBL][D + i]; ((float*)(F.ws + WS_MOD + 245760))[i] = 1.f / (1.f + expf(l0 - l1)); }
    const int gt = F.vcu * NWAVES * 64 + F.tid, NGT = F.G * NWAVES * 64;
    for (int i = gt; i < 224 * D / 8; i += NGT) ((GAS v4u*)(F.ws + WS_W_IN0 + (size_t)ABC * D * 2))[i] = (v4u){0u, 0u, 0u, 0u};
    for (int i = gt; i < 2 * NE * D; i += NGT) { const int l = i / (NE * D), e = (i / D) % NE, k = i % D;
        const float w = A.in[I_ROUTER][((size_t)l * D + k) * NE + e]; const unsigned hi = f2bf(w); const float lo = w - bf2f(hi);
        bf16* rt = (bf16*)(F.ws + WS_W_RT) + (size_t)l * 2 * NE * D;
        const size_t o = ((size_t)((e >> 4) * 32 + (k >> 5)) * 64 + ((k >> 3) & 3) * 16 + (e & 15)) * 8 + (k & 7);
        rt[o] = (bf16)hi; rt[(size_t)NE * D + o] = (bf16)f2bf(lo); }
}

template <int CTRL, int ROWMASK> __device__ __forceinline__ float dpp_add(float v) { return v + __builtin_bit_cast(float, __builtin_amdgcn_update_dpp(0, __builtin_bit_cast(int, v), CTRL, ROWMASK, 0xf, false)); }
__device__ __forceinline__ float row_sum16(float v) { v = dpp_add<0xB1, 0xf>(v); v = dpp_add<0x4E, 0xf>(v); v = dpp_add<0x141, 0xf>(v); v = dpp_add<0x140, 0xf>(v); return v; }
__device__ __forceinline__ float wsum(float v) {
    v = row_sum16(v);
    v = dpp_add<0x142, 0xa>(v);
    v = dpp_add<0x143, 0xc>(v);
    return __builtin_bit_cast(float, __builtin_amdgcn_readlane(__builtin_bit_cast(int, v), 63));
}
__device__ __forceinline__ void row_load_f32(const float* p, int lane, f32x4 (&v)[4]) {
#pragma unroll
    for (int j = 0; j < 4; ++j) v[j] = ((const GAS f32x4*)p)[lane + 64 * j];
}
__device__ __forceinline__ void row_load_bf16(const bf16* p, int lane, f32x4 (&v)[4]) {
#pragma unroll
    for (int j = 0; j < 4; ++j) { const v2u w = ((const GAS v2u*)p)[lane + 64 * j]; v[j] = (f32x4){bflo(w.x), bfhi(w.x), bflo(w.y), bfhi(w.y)}; }
}
__device__ __forceinline__ void row_load_f8(const unsigned char* p, int lane, f32x4 (&v)[4]) {
#pragma unroll
    for (int j = 0; j < 4; ++j) { const int w = (int)((const GAS unsigned*)p)[lane + 64 * j]; const f32x2 lo = __builtin_amdgcn_cvt_pk_f32_fp8(w, false), hi = __builtin_amdgcn_cvt_pk_f32_fp8(w, true); v[j] = (f32x4){lo.x, lo.y, hi.x, hi.y}; }
}
__device__ __forceinline__ float row_ss(const f32x4 (&v)[4]) {
    float s = 0.f;
#pragma unroll
    for (int j = 0; j < 4; ++j) s += (v[j].x * v[j].x + v[j].y * v[j].y) + (v[j].z * v[j].z + v[j].w * v[j].w);
    return wsum(s);
}
__device__ __forceinline__ void row_store_bf16(bf16* p, int lane, const f32x4 (&v)[4]) {
#pragma unroll
    for (int j = 0; j < 4; ++j) { v2u w; w.x = hwpk2(v[j].x, v[j].y); w.y = hwpk2(v[j].z, v[j].w); ((GAS v2u*)p)[lane + 64 * j] = w; }
}
__device__ __forceinline__ void row_prenorm(const f32x4 (&x)[4], float rstd, const float* gain, const float* mscale, const float* mshift, int lane, f32x4 (&h)[4]) {
#pragma unroll
    for (int j = 0; j < 4; ++j) { const f32x4 g = ((const GAS f32x4*)gain)[lane + 64 * j], sc = ((const GAS f32x4*)mscale)[lane + 64 * j], sh = ((const GAS f32x4*)mshift)[lane + 64 * j];
        h[j] = x[j] * rstd * g * (sc + 1.0f) + sh; }
}

__device__ __forceinline__ void p1_prenorm0(Frame& F, const Args& A) {
    const int gw = F.vcu * NWAVES + F.wave, NGW = F.G * NWAVES;
    const float* Ml = (const float*)(F.ws + WS_MOD);
    bf16* H0 = (bf16*)(F.ws + WS_B + B_H0);
    LAS float* mp = (LAS float*)F.lds; LAS float* ms = mp + 5 * D;
    for (int i = F.tid; i < 5 * D; i += NWAVES * 64) { const int v = i >> 10, c = i & (D - 1); const float* m = Ml + (size_t)v * NMOD; mp[i] = A.in[I_PREG][c] * (1.0f + m[1 * D + c]); ms[i] = m[0 * D + c]; }
    __syncthreads();
#pragma unroll 4
    for (int row = gw; row < R; row += NGW) {
        const int v = mod_row(row);
        f32x4 x[4], h[4];
        row_load_f32(row_src(A.in[I_X], A.in[I_CTX], row), F.lane, x);
        const float rstd = rsqrtf(row_ss(x) * (1.f / D) + EPS);
#pragma unroll
        for (int j = 0; j < 4; ++j) h[j] = x[j] * rstd * *(const LAS f32x4*)(mp + v * D + 4 * (F.lane + 64 * j)) + *(const LAS f32x4*)(ms + v * D + 4 * (F.lane + 64 * j));
        row_store_bf16(H0 + (size_t)row * D, F.lane, h);
    }
}

struct SchedPlain {
    const bf16* Ap; const bf16* Bt; int K, nM, nN, G, c, lat_only;
    __device__ __forceinline__ bool next(int i, pg8::Unit& u) const {
        const int nwg = nM * nN; const long L = (long)i * G + c; if (L >= nwg) return false;
        const int wgid = pg8::xcd_remap((int)L, nwg);
        const int nig = pg8::WGM * nN, gid = wgid / nig, fm = gid * pg8::WGM, gsz = (nM - fm) < pg8::WGM ? (nM - fm) : pg8::WGM;
        u.pm = fm + ((wgid % nig) % gsz); u.pn = (wgid % nig) / gsz; u.e = 0;
        u.arow0 = lat_only ? ((u.pm >> 4) * T + CTX + (u.pm & 15) * 256) : u.pm * 256;
        return true;
    }
    __device__ __forceinline__ void a_offs(const pg8::Unit& u, unsigned (&v)[2][2], int tid) const {
#pragma unroll
        for (int i = 0; i < 2; ++i) { int R_, C_; pg8::stage_rc(tid * 16 + i * 8192, R_, C_);
            v[0][i] = (unsigned)((u.arow0 + R_) * K + C_) * 2u; v[1][i] = (unsigned)((u.arow0 + pg8::HALF + R_) * K + C_) * 2u; }
    }
    __device__ __forceinline__ const char* a_base() const { return (const char*)Ap; }
    __device__ __forceinline__ const char* b_base(const pg8::Unit& u) const { return (const char*)Bt + (size_t)u.pn * 256 * K * 2; }
};

template <int ACT, bool F16>
__device__ __forceinline__ void store_tile16(const f32x4 (&acc)[2][2][4][2], unsigned short* dst, int ld, int row0, int wr, int wc, int fr, int fq, float scale) {
#pragma unroll
    for (int ai = 0; ai < 2; ++ai)
#pragma unroll
        for (int m = 0; m < 4; ++m) { unsigned short* rowp = dst + (size_t)(row0 + ai * 128 + wr * 64 + m * 16 + fr) * ld + wc * 32 + 8 * fq;
#pragma unroll
            for (int bj = 0; bj < 2; ++bj) { f32x4 v0 = acc[ai][bj][m][0], v1 = acc[ai][bj][m][1];
                if (ACT == 1) {
#pragma unroll
                    for (int j = 0; j < 4; ++j) { v0[j] = fgelu(v0[j]); v1[j] = fgelu(v1[j]); } }
                if (ACT == 2) {
#pragma unroll
                    for (int j = 0; j < 4; ++j) { v0[j] = fsilu(v0[j]); v1[j] = fsilu(v1[j]); } }
                if (ACT == 3) { v0 = v0 * scale; v1 = v1 * scale; }
                v4u w;
                if (F16) { w.x = pk2h(v0[0], v0[1]); w.y = pk2h(v0[2], v0[3]); w.z = pk2h(v1[0], v1[1]); w.w = pk2h(v1[2], v1[3]); }
                else { w.x = cvt_pk_bf16(v0[0], v0[1]); w.y = cvt_pk_bf16(v0[2], v0[3]); w.z = cvt_pk_bf16(v1[0], v1[1]); w.w = cvt_pk_bf16(v1[2], v1[3]); }
                *(GAS v4u*)(rowp + bj * 128) = w; } }
}
struct EpiIn0 {
    unsigned char* a;
    __device__ __forceinline__ bool full(const pg8::Unit& u) const { return u.pn < 20; }
    __device__ __forceinline__ void operator()(const f32x4 (&acc)[2][2][4][2], const pg8::Unit& u, int wr, int wc, int fr, int fq) const {
        const int pn = u.pn, r0 = u.arow0;
        if (pn < 4) store_tile16<1, false>(acc, (bf16*)(a + A_GX) + pn * 256, D, r0, wr, wc, fr, fq, 1.f);
        else if (pn < 8) store_tile16<0, false>(acc, (bf16*)(a + A_XL) + (pn - 4) * 256, D, r0, wr, wc, fr, fq, 1.f);
        else if (pn < 10) store_tile16<3, false>(acc, (bf16*)(a + A_Q) + (pn - 8) * 256, 512, r0, wr, wc, fr, fq, 0.08838834764831845f);
        else if (pn < 12) store_tile16<0, false>(acc, (bf16*)(a + A_K) + (pn - 10) * 256, 512, r0, wr, wc, fr, fq, 1.f);
        else if (pn < 16) store_tile16<0, false>(acc, (bf16*)(a + A_V) + (pn - 12) * 256, D, r0, wr, wc, fr, fq, 1.f);
        else if (pn < 20) store_tile16<2, false>(acc, (bf16*)(a + A_SG) + (pn - 16) * 256, D, r0, wr, wc, fr, fq, 1.f);
        else if (wc == 0) {
            f16b* dst = (f16b*)(a + A_ALR);
#pragma unroll
            for (int ai = 0; ai < 2; ++ai)
#pragma unroll
                for (int m = 0; m < 4; ++m) { const f32x4 v0 = acc[ai][0][m][0], v1 = acc[ai][0][m][1];
                    v4u w; w.x = pk2h(v0[0], v0[1]); w.y = pk2h(v0[2], v0[3]); w.z = pk2h(v1[0], v1[1]); w.w = pk2h(v1[2], v1[3]);
                    *(GAS v4u*)(dst + (size_t)(r0 + ai * 128 + wr * 64 + m * 16 + fr) * 32 + 8 * fq) = w; }
        }
    }
};

__device__ __forceinline__ void p2_tail(Frame& F, const Args& A);
__device__ __forceinline__ void p2_inproj0(Frame& F, const Args& A) {
    SchedPlain S{(const bf16*)(F.ws + WS_B + B_H0), (const bf16*)(F.ws + WS_W_IN0), D, R / 256, NIN0 / 256, F.G, (int)blockIdx.x, 0};
    EpiIn0 E{F.ws + WS_A};
    pg8::gemm_phase<EpiIn0, SchedPlain>(F.lds, D, S, E);
    p2_tail(F, A);
}

__device__ __forceinline__ unsigned off_b(unsigned row, unsigned ch) { return 256u * row + 16u * (ch ^ (((row & 3u) << 2) | ((row >> 2) & 3u))); }
__device__ __forceinline__ bf16x8 row_frag(const LAS unsigned char* img, unsigned row0, unsigned lane, unsigned s) { return *(const LAS bf16x8*)(img + off_b(row0 + (lane & 31u), 2u * s + (lane >> 5))); }
__device__ __forceinline__ unsigned tr_addr(unsigned lane, unsigned c, unsigned t) {
    const unsigned h = lane >> 5, blk = (lane >> 4) & 1u, q = (lane & 15u) >> 2, p = lane & 3u;
    return off_b(8u * h + 4u * t + q, 4u * c + 2u * blk + (p >> 1)) + 8u * (p & 1u);
}
__device__ __forceinline__ void tr_read_k64(unsigned a0, unsigned a1, bf16x8 (&f)[4]) {
    v2u r00, r01, r10, r11, r20, r21, r30, r31;
    asm volatile("ds_read_b64_tr_b16 %0, %8\n\tds_read_b64_tr_b16 %1, %9\n\tds_read_b64_tr_b16 %2, %8 offset:4096\n\tds_read_b64_tr_b16 %3, %9 offset:4096\n\t"
                 "ds_read_b64_tr_b16 %4, %8 offset:8192\n\tds_read_b64_tr_b16 %5, %9 offset:8192\n\tds_read_b64_tr_b16 %6, %8 offset:12288\n\tds_read_b64_tr_b16 %7, %9 offset:12288\n\ts_waitcnt lgkmcnt(0)"
                 : "=&v"(r00), "=&v"(r01), "=&v"(r10), "=&v"(r11), "=&v"(r20), "=&v"(r21), "=&v"(r30), "=&v"(r31) : "v"(a0), "v"(a1) : "memory");
    f[0] = __builtin_bit_cast(bf16x8, (v4u){r00.x, r00.y, r01.x, r01.y}); f[1] = __builtin_bit_cast(bf16x8, (v4u){r10.x, r10.y, r11.x, r11.y});
    f[2] = __builtin_bit_cast(bf16x8, (v4u){r20.x, r20.y, r21.x, r21.y}); f[3] = __builtin_bit_cast(bf16x8, (v4u){r30.x, r30.y, r31.x, r31.y});
}
__device__ __forceinline__ unsigned lds_addr(const LAS unsigned char* p) { return (unsigned)(unsigned long)p; }
#define MFMA32(a, b, c) __builtin_amdgcn_mfma_f32_32x32x16_bf16((a), (b), (c), 0, 0, 0)
__device__ __forceinline__ float flogsigm(float z) { return fminf(z, 0.f) - 0.6931471805599453f * __builtin_amdgcn_logf(1.f + fexp(-fabsf(z))); }
__device__ __forceinline__ f32x16 zero16() { f32x16 z; for (int i = 0; i < 16; ++i) z[i] = 0.f; return z; }
__device__ __forceinline__ int chunk_scan_index(int c, int dir) { return dir ? (c < 4 ? 3 - c : 71 - c) : c; }

struct ChunkP {
    const bf16* q; int ldq;
    const bf16* k; int ldk;
    const bf16* v; int ldv;
    const f16b* alr;
    const float* wa2; const float* gba;
    const f16b* z[2];
    const float* lbl;
    const bf16* sg; bf16* y; int ldy, ycol0;
    bf16* kv; float* dec;
};

__device__ __forceinline__ void unpack8(const v4u w, float (&f)[8]) { f[0] = bflo(w.x); f[1] = bfhi(w.x); f[2] = bflo(w.y); f[3] = bfhi(w.y); f[4] = bflo(w.z); f[5] = bfhi(w.z); f[6] = bflo(w.w); f[7] = bfhi(w.w); }
template <int DV>
__device__ __forceinline__ void load_v_tile(const Frame& F, const bf16* v, int ldv, size_t row0, int col0, LAS unsigned char* Vimg) {
    constexpr int CPR = DV / 8;
    constexpr int NT_ = 64 * CPR / (NWAVES * 64);
    v4u w[NT_];
#pragma unroll
    for (int t = 0; t < NT_; ++t) { const int i = F.tid + t * NWAVES * 64, m = i / CPR, chx = i % CPR; w[t] = *(const GAS v4u*)(v + (row0 + m) * ldv + col0 + chx * 8); }
#pragma unroll
    for (int t = 0; t < NT_; ++t) { const int i = F.tid + t * NWAVES * 64, m = i / CPR, chx = i % CPR; *(LAS v4u*)(Vimg + (chx >> 4) * 16384 + off_b(m, chx & 15)) = w[t]; }
}
__device__ __forceinline__ void load_alr_tile(const Frame& F, const f16b* alr, size_t row0, LAS float* alr_s) {
    int t_ = F.tid; asm volatile("" : "+v"(t_));
    const v2u w = *(const GAS v2u*)(alr + row0 * 32 + t_ * 4);
    *(LAS f32x4*)(alr_s + t_ * 4) = (f32x4){h2f((unsigned short)(w.x & 0xffffu)), h2f((unsigned short)(w.x >> 16)), h2f((unsigned short)(w.y & 0xffffu)), h2f((unsigned short)(w.y >> 16))};
}
__device__ __forceinline__ void stage_raw_tile(const Frame& F, const unsigned short* src, int ld, size_t row0, int col0, LAS unsigned char* dst) {
    v4u w[2];
#pragma unroll
    for (int t = 0; t < 2; ++t) { const int i = F.tid + t * NWAVES * 64, m = i >> 4, ch = i & 15; w[t] = *(const GAS v4u*)(src + (row0 + m) * ld + col0 + ch * 8); }
#pragma unroll
    for (int t = 0; t < 2; ++t) { const int i = F.tid + t * NWAVES * 64, m = i >> 4, ch = i & 15; *(LAS v4u*)(dst + m * 272 + ch * 16) = w[t]; }
}
struct SegIn { unsigned q[8]; unsigned kz[8]; float w[16]; float bias; };
template <bool HG, bool WITHQ>
__device__ __forceinline__ void seg_load(const ChunkP& P, const LAS unsigned char* rawq, const LAS unsigned char* rawk, int h, int d, int seg, int dir, SegIn& S) {
#pragma unroll
    for (int i = 0; i < 16; i += 2) { const int p = seg * 16 + i, m0 = dir ? 63 - p : p, m1 = dir ? m0 - 1 : m0 + 1;
        if (WITHQ) S.q[i >> 1] = (unsigned)*(const LAS unsigned short*)(rawq + m0 * 272 + d * 2) | ((unsigned)*(const LAS unsigned short*)(rawq + m1 * 272 + d * 2) << 16);
        S.kz[i >> 1] = (unsigned)*(const LAS unsigned short*)(rawk + m0 * 272 + d * 2) | ((unsigned)*(const LAS unsigned short*)(rawk + m1 * 272 + d * 2) << 16); }
    if (!HG) {
#pragma unroll
        for (int r = 0; r < 16; ++r) S.w[r] = P.wa2[((size_t)dir * 16 + r) * 512 + h * 128 + d];
        S.bias = P.gba[dir * 512 + h * 128 + d];
    }
}
template <bool HG>
__device__ __forceinline__ void seg_load_g(const ChunkP& P, size_t row0, int h, int d, int seg, int dir, SegIn& S) {
    const unsigned short* kp = HG ? (const unsigned short*)((dir ? P.z[1] : P.z[0]) + row0 * D + h * 128 + d) : (const unsigned short*)(P.k + row0 * P.ldk + h * 128 + d);
    const int ldk = HG ? D : P.ldk;
#pragma unroll
    for (int i = 0; i < 16; i += 2) { const int p = seg * 16 + i, m0 = dir ? 63 - p : p, m1 = dir ? m0 - 1 : m0 + 1;
        S.kz[i >> 1] = (unsigned)((const GAS unsigned short*)kp)[(size_t)m0 * ldk] | ((unsigned)((const GAS unsigned short*)kp)[(size_t)m1 * ldk] << 16); }
    if (!HG) {
#pragma unroll
        for (int r = 0; r < 16; ++r) S.w[r] = P.wa2[((size_t)dir * 16 + r) * 512 + h * 128 + d];
        S.bias = P.gba[dir * 512 + h * 128 + d];
    }
}
template <bool HG>
__device__ __forceinline__ float seg_gates(const SegIn& S, float lb, int seg, int dir, const LAS float* alr_s, float (&g)[16], float (&kf)[16]) {
#pragma unroll
    for (int i = 0; i < 16; ++i) {
        const unsigned short kzi = (unsigned short)((i & 1) ? (S.kz[i >> 1] >> 16) : (S.kz[i >> 1] & 0xffffu));
        if (HG) { const float sg_ = fsigm(h2f(kzi)); g[i] = 0.6931471805599453f * __builtin_amdgcn_logf(lb + (1.f - lb) * sg_); kf[i] = (1.f - lb) * (1.f - sg_); }
        else { const int p = seg * 16 + i, m = dir ? 63 - p : p; float zz = S.bias;
#pragma unroll
            for (int r = 0; r < 16; ++r) zz += alr_s[m * 32 + dir * 16 + r] * S.w[r];
            g[i] = flogsigm(zz) * (1.f / 16.f); kf[i] = bf2f(kzi); }
    }
    float run = 0.f;
#pragma unroll
    for (int i = 0; i < 16; ++i) { run += g[i]; g[i] = run; }
    return run;
}
__device__ __forceinline__ unsigned tr_addr2(unsigned lane, unsigned c, unsigned t) {
    const unsigned h = lane >> 5, blk = (lane >> 4) & 1u, q = (lane & 15u) >> 2, p = lane & 3u;
    return off_b(8u * t + 4u * h + q, 4u * c + 2u * blk + (p >> 1)) + 8u * (p & 1u);
}
__device__ __forceinline__ void tr_read_perm32(unsigned a0, unsigned a1, bf16x8 (&f)[2]) {
    v2u r00, r01, r10, r11;
    asm volatile("ds_read_b64_tr_b16 %0, %4\n\tds_read_b64_tr_b16 %1, %5\n\tds_read_b64_tr_b16 %2, %4 offset:4096\n\tds_read_b64_tr_b16 %3, %5 offset:4096\n\ts_waitcnt lgkmcnt(0)"
                 : "=&v"(r00), "=&v"(r01), "=&v"(r10), "=&v"(r11) : "v"(a0), "v"(a1) : "memory");
    f[0] = __builtin_bit_cast(bf16x8, (v4u){r00.x, r00.y, r01.x, r01.y}); f[1] = __builtin_bit_cast(bf16x8, (v4u){r10.x, r10.y, r11.x, r11.y});
}
__device__ __forceinline__ void st16(LAS unsigned char* img, int m, int d, float v) { *(LAS unsigned short*)(img + off_b(m, d >> 3) + (d & 7) * 2) = hwbf(v); }

template <int DV, bool HG>
__device__ __forceinline__ void chunk_pass1(const Frame& F, const ChunkP& P, int NH, int v0) {
    LAS unsigned char* Kd = F.lds;
    LAS unsigned char* Vimg = F.lds + 16384;
    LAS unsigned char* Ost = F.lds + 49152;
    LAS float* segtot = (LAS float*)(F.lds + 118784);
    LAS float* alr_s = (LAS float*)(F.lds + 120832);
    LAS unsigned char* rawk = F.lds + 129024;
    const int nitems = NB * NH * 2 * NCH;
    const int d = F.tid & 127, seg = F.tid >> 7;
    constexpr int NVT = 64 * (DV / 8) / (NWAVES * 64);
    v4u pfv[NVT], pfk[2]; v2u pfa; unsigned pkz[8]; float pw[16], pbias;
#define P1_PREFETCH(it_) do { const int c_ = (it_) % NCH, dir_ = ((it_) / NCH) & 1, h_ = ((it_) / (2 * NCH)) % NH, b_ = (it_) / (2 * NCH * NH); const size_t r0_ = (size_t)b_ * T + (size_t)c_ * 64; \
        _Pragma("unroll") for (int t = 0; t < NVT; ++t) { const int i = F.tid + t * NWAVES * 64, m = i / (DV / 8), chx = i % (DV / 8); pfv[t] = *(const GAS v4u*)(P.v + (r0_ + m) * P.ldv + h_ * DV + chx * 8); } \
        if (HG) { const unsigned short* kp_ = (const unsigned short*)((dir_ ? P.z[1] : P.z[0]) + r0_ * D + h_ * 128 + d); \
            _Pragma("unroll") for (int i = 0; i < 16; i += 2) { const int p = seg * 16 + i, m0 = dir_ ? 63 - p : p, m1 = dir_ ? m0 - 1 : m0 + 1; \
                pkz[i >> 1] = (unsigned)((const GAS unsigned short*)kp_)[(size_t)m0 * D] | ((unsigned)((const GAS unsigned short*)kp_)[(size_t)m1 * D] << 16); } } \
        else { _Pragma("unroll") for (int t = 0; t < 2; ++t) { const int i = F.tid + t * NWAVES * 64, m = i >> 4, ch = i & 15; pfk[t] = *(const GAS v4u*)(P.k + (r0_ + m) * P.ldk + h_ * 128 + ch * 8); } \
            pfa = *(const GAS v2u*)(P.alr + r0_ * 32 + F.tid * 4); \
            _Pragma("unroll") for (int r = 0; r < 16; ++r) pw[r] = P.wa2[((size_t)dir_ * 16 + r) * 512 + h_ * 128 + d]; \
            pbias = P.gba[dir_ * 512 + h_ * 128 + d]; } } while (0)
    if (v0 < nitems) P1_PREFETCH(v0);
    for (int item = v0; item < nitems; item += F.G) {
        const int c = item % NCH, dir = (item / NCH) & 1, h = (item / (2 * NCH)) % NH, b = item / (2 * NCH * NH);
        const float lb = HG ? P.lbl[h * 128 + d] : 0.f;
        SegIn S;
#pragma unroll
        for (int t = 0; t < NVT; ++t) { const int i = F.tid + t * NWAVES * 64, m = i / (DV / 8), chx = i % (DV / 8); *(LAS v4u*)(Vimg + (chx >> 4) * 16384 + off_b(m, chx & 15)) = pfv[t]; }
        if (HG) {
#pragma unroll
            for (int j = 0; j < 8; ++j) S.kz[j] = pkz[j]; }
        else {
#pragma unroll
            for (int t = 0; t < 2; ++t) { const int i = F.tid + t * NWAVES * 64, m = i >> 4, ch = i & 15; *(LAS v4u*)(rawk + m * 272 + ch * 16) = pfk[t]; }
            *(LAS f32x4*)(alr_s + F.tid * 4) = (f32x4){h2f((unsigned short)(pfa.x & 0xffffu)), h2f((unsigned short)(pfa.x >> 16)), h2f((unsigned short)(pfa.y & 0xffffu)), h2f((unsigned short)(pfa.y >> 16))};
#pragma unroll
            for (int r = 0; r < 16; ++r) S.w[r] = pw[r];
            S.bias = pbias; }
        if (item + F.G < nitems) P1_PREFETCH(item + F.G);
        if (!HG) { __syncthreads();
#pragma unroll
            for (int i = 0; i < 16; i += 2) { const int p = seg * 16 + i, m0 = dir ? 63 - p : p, m1 = dir ? m0 - 1 : m0 + 1;
                S.kz[i >> 1] = (unsigned)*(const LAS unsigned short*)(rawk + m0 * 272 + d * 2) | ((unsigned)*(const LAS unsigned short*)(rawk + m1 * 272 + d * 2) << 16); } }
        float g[16], kf[16];
        segtot[seg * 128 + d] = seg_gates<HG>(S, lb, seg, dir, alr_s, g, kf);
        __syncthreads();
        float offs = 0.f, blast = 0.f;
#pragma unroll
        for (int s2 = 0; s2 < 4; ++s2) { const float t_ = segtot[s2 * 128 + d]; blast += t_; offs += (s2 < seg) ? t_ : 0.f; }
#pragma unroll
        for (int i = 0; i < 16; ++i) { const int p = seg * 16 + i, m = dir ? 63 - p : p; st16(Kd, m, d, kf[i] * fexp(blast - (g[i] + offs))); }
        const int stream = (b * NH + h) * 2 + dir, cs = chunk_scan_index(c, dir);
        if (seg == 0) P.dec[((size_t)stream * NCH + cs) * 128 + d] = fexp(blast);
        __syncthreads();
        const int et = (DV == 256) ? F.wave : (F.wave >> 1), dt0 = (DV == 256) ? 0 : 2 * (F.wave & 1);
        constexpr int NDT = (DV == 256) ? 4 : 2;
        bf16* kvp = P.kv + ((size_t)stream * NCH + cs) * (DV * 128);
        bf16x8 af[4];
        { const unsigned base = lds_addr(Vimg + (et >> 2) * 16384); tr_read_k64(base + tr_addr(F.lane, et & 3, 0), base + tr_addr(F.lane, et & 3, 1), af); }
#pragma unroll
        for (int t = 0; t < NDT; ++t) { const int dt = dt0 + t;
            bf16x8 bfr[4];
            { const unsigned base = lds_addr(Kd); tr_read_k64(base + tr_addr(F.lane, dt, 0), base + tr_addr(F.lane, dt, 1), bfr); }
            f32x16 acc = zero16();
#pragma unroll
            for (int ks = 0; ks < 4; ++ks) acc = MFMA32(af[ks], bfr[ks], acc);
            LAS unsigned char* ob = Ost + (32 * et + 4 * (F.lane >> 5)) * 272 + (32 * dt + (F.lane & 31)) * 2;
#pragma unroll
            for (int r = 0; r < 16; ++r) *(LAS unsigned short*)(ob + ((r & 3) + 8 * (r >> 2)) * 272) = hwbf(acc[r]);
        }
        __syncthreads();
        for (int i = F.tid; i < DV * 16; i += NWAVES * 64) { const int l31 = i & 31, hf = (i >> 5) & 1, s = (i >> 6) & 7, etq = i >> 9, e = 32 * etq + l31, ch = 2 * s + hf;
            *(GAS v4u*)(kvp + (size_t)i * 8) = *(const LAS v4u*)(Ost + e * 272 + ch * 16); }
    }
#undef P1_PREFETCH
}

__device__ __forceinline__ void chunk_scan(const Frame& F, bf16* kv, const float* dec, int nstreams, int DVv) {
    const int per_stream = DVv * 128 / 8;
    const long ntask = (long)nstreams * per_stream;
    for (long task = (long)F.vcu * (NWAVES * 64) + F.tid; task < ntask; task += (long)F.G * NWAVES * 64) {
        const int stream = (int)(task / per_stream), el = (int)(task % per_stream), d0 = 16 * ((el >> 6) & 7) + 8 * ((el >> 5) & 1);
        bf16* p = kv + (size_t)stream * NCH * (DVv * 128) + (size_t)el * 8;
        const float* dp = dec + (size_t)stream * NCH * 128 + d0;
        float S[8];
#pragma unroll
        for (int j = 0; j < 8; ++j) S[j] = 0.f;
#pragma unroll 4
        for (int cs = 0; cs < NCH; ++cs) {
            const v4u w = *(const GAS v4u*)(p + (size_t)cs * (DVv * 128));
            const f32x4 da = *(const GAS f32x4*)(dp + (size_t)cs * 128), db = *(const GAS f32x4*)(dp + (size_t)cs * 128 + 4);
            v4u o; o.x = hwpk2(S[0], S[1]); o.y = hwpk2(S[2], S[3]); o.z = hwpk2(S[4], S[5]); o.w = hwpk2(S[6], S[7]);
            *(GAS v4u*)(p + (size_t)cs * (DVv * 128)) = o;
            S[0] = da.x * S[0] + bflo(w.x); S[1] = da.y * S[1] + bfhi(w.x); S[2] = da.z * S[2] + bflo(w.y); S[3] = da.w * S[3] + bfhi(w.y);
            S[4] = db.x * S[4] + bflo(w.z); S[5] = db.y * S[5] + bfhi(w.z); S[6] = db.z * S[6] + bflo(w.w); S[7] = db.w * S[7] + bfhi(w.w);
        }
    }
}

template <int DV, bool HG>
__device__ __forceinline__ void chunk_pass2(const Frame& F, const ChunkP& P, int NH, int first_chunk, int v0) {
    LAS unsigned char* T0 = F.lds;
    LAS unsigned char* rawq = F.lds + 49152;
    LAS unsigned char* rawk0 = F.lds + 66560;
    LAS unsigned char* rawk1 = F.lds + 83968;
    LAS unsigned char* Vimg = F.lds + 101376;
    LAS float* segtot = (LAS float*)(F.lds + 134144);
    LAS float* alr_s = (LAS float*)(F.lds + 138240);
    LAS float* rowsq = (LAS float*)(F.lds + 146432);
    LAS float* Ost = (LAS float*)F.lds;
    const int nch = NCH - first_chunk, nitems = NB * NH * nch;
    constexpr int NIT = (DV == 256) ? 2 : 1;
    constexpr int OLD = DV + 4;
    const int d = F.tid & 127, seg = F.tid >> 7;
    constexpr int NVT = 64 * (DV / 8) / (NWAVES * 64);
    v4u pfv[NVT], pfq[2], pfk[HG ? 4 : 2]; v2u pfa;
    const char* wsb = (const char*)F.ws;
    const unsigned ov_ = (unsigned)((const char*)P.v - wsb), oq_ = (unsigned)((const char*)P.q - wsb), ok_ = HG ? (unsigned)((const char*)P.z[0] - wsb) : (unsigned)((const char*)P.k - wsb),
                   oz1_ = HG ? (unsigned)((const char*)P.z[1] - wsb) : 0u, oa_ = HG ? 0u : (unsigned)((const char*)P.alr - wsb);
#define P2_PREFETCH(item_) do { const int c_ = first_chunk + (item_) % nch, h_ = ((item_) / nch) % NH, b_ = (item_) / (nch * NH); const unsigned r0_ = (unsigned)(b_ * T + c_ * 64); \
        _Pragma("unroll") for (int t = 0; t < NVT; ++t) { const int i = F.tid + t * NWAVES * 64, m = i / (DV / 8), chx = i % (DV / 8); pfv[t] = *(const GAS v4u*)(wsb + (size_t)(ov_ + ((r0_ + m) * (unsigned)P.ldv + h_ * DV + chx * 8) * 2u)); } \
        _Pragma("unroll") for (int t = 0; t < 2; ++t) { const int i = F.tid + t * NWAVES * 64, m = i >> 4, ch = i & 15; \
            pfq[t] = *(const GAS v4u*)(wsb + (size_t)(oq_ + ((r0_ + m) * (unsigned)P.ldq + h_ * 128 + ch * 8) * 2u)); \
            if (HG) { pfk[t] = *(const GAS v4u*)(wsb + (size_t)(ok_ + ((r0_ + m) * (unsigned)D + h_ * 128 + ch * 8) * 2u)); pfk[2 + t] = *(const GAS v4u*)(wsb + (size_t)(oz1_ + ((r0_ + m) * (unsigned)D + h_ * 128 + ch * 8) * 2u)); } \
            else pfk[t] = *(const GAS v4u*)(wsb + (size_t)(ok_ + ((r0_ + m) * (unsigned)P.ldk + h_ * 128 + ch * 8) * 2u)); } \
        if (!HG) pfa = *(const GAS v2u*)(wsb + (size_t)(oa_ + (r0_ * 32u + F.tid * 4) * 2u)); } while (0)
    if (v0 < nitems) P2_PREFETCH(v0);
    for (int item = v0; item < nitems; item += F.G) {
        const int c = first_chunk + item % nch, h = (item / nch) % NH, b = item / (nch * NH);
        const size_t row0 = (size_t)b * T + (size_t)c * 64;
        const int et = (DV == 256) ? F.wave : (F.wave >> 1), it0 = (DV == 256) ? 0 : (F.wave & 1);
        f32x16 acc[NIT];
#pragma unroll
        for (int t = 0; t < NIT; ++t) acc[t] = zero16();
        const float lb = HG ? P.lbl[h * 128 + d] : 0.f;
        if (!HG) *(LAS f32x4*)(alr_s + F.tid * 4) = (f32x4){h2f((unsigned short)(pfa.x & 0xffffu)), h2f((unsigned short)(pfa.x >> 16)), h2f((unsigned short)(pfa.y & 0xffffu)), h2f((unsigned short)(pfa.y >> 16))};
#pragma unroll
        for (int t = 0; t < NVT; ++t) { const int i = F.tid + t * NWAVES * 64, m = i / (DV / 8), chx = i % (DV / 8); *(LAS v4u*)(Vimg + (chx >> 4) * 16384 + off_b(m, chx & 15)) = pfv[t]; }
#pragma unroll
        for (int t = 0; t < 2; ++t) { const int i = F.tid + t * NWAVES * 64, m = i >> 4, ch = i & 15;
            *(LAS v4u*)(rawq + m * 272 + ch * 16) = pfq[t]; *(LAS v4u*)(rawk0 + m * 272 + ch * 16) = pfk[t];
            if (HG) *(LAS v4u*)(rawk1 + m * 272 + ch * 16) = pfk[2 + t]; }
        __syncthreads();
        bf16x8 vpm[2][2];
#pragma unroll 1
        for (int dir = 0; dir < 2; ++dir) {
            LAS unsigned char* Qt = T0; LAS unsigned char* Kt = Qt + 16384; LAS unsigned char* Qd = Qt + 32768;
            SegIn S; seg_load<HG, true>(P, rawq, (HG && dir) ? rawk1 : rawk0, h, d, seg, dir, S);
            const int stream = (b * NH + h) * 2 + dir, cs = chunk_scan_index(c, dir);
            const bf16* sp = P.kv + ((size_t)stream * NCH + cs) * (DV * 128) + (size_t)et * 4096 + F.lane * 8;
            bf16x8 sfr[8];
            float g[16], kf[16];
            segtot[(dir * 4 + seg) * 128 + d] = seg_gates<HG>(S, lb, seg, dir, alr_s, g, kf);
            if (HG) {
#pragma unroll
                for (int s = 0; s < 8; ++s) sfr[s] = *(const GAS bf16x8*)(sp + 512 * s); }
            __syncthreads();
            float offs = 0.f;
#pragma unroll
            for (int s2 = 0; s2 < 3; ++s2) offs += (s2 < seg) ? segtot[(dir * 4 + s2) * 128 + d] : 0.f;
            const float bref = segtot[(dir * 4 + 0) * 128 + d] + segtot[(dir * 4 + 1) * 128 + d];
            const float eref = fexp(bref);
#pragma unroll
            for (int i = 0; i < 16; ++i) { const int p = seg * 16 + i, m = dir ? 63 - p : p; const float B = g[i] + offs, qf = (i & 1) ? bfhi(S.q[i >> 1]) : bflo(S.q[i >> 1]);
                const float e1 = fexp(B - bref), qe = qf * e1;
                st16(Qt, m, d, qe); st16(Kt, m, d, kf[i] * frcp(e1)); st16(Qd, m, d, qe * eref); }
            __syncthreads();
            if (!HG) {
#pragma unroll
                for (int s = 0; s < 8; ++s) sfr[s] = *(const GAS bf16x8*)(sp + 512 * s); }
            if (dir == 0) {
#pragma unroll
                for (int jt = 0; jt < 2; ++jt) { const unsigned base = lds_addr(Vimg + (et >> 2) * 16384) + jt * 8192; tr_read_perm32(base + tr_addr2(F.lane, et & 3, 0), base + tr_addr2(F.lane, et & 3, 1), vpm[jt]); }
            }
#pragma unroll
            for (int t = 0; t < NIT; ++t) { const int it = it0 + t;
#pragma unroll
                for (int jt = 0; jt < 2; ++jt) {
                    const bool skip = dir ? (jt < it) : (jt > it);
                    if (!skip) {
                        f32x16 pa = zero16();
#pragma unroll
                        for (int s = 0; s < 8; ++s) pa = MFMA32(row_frag(Kt, 32 * jt, F.lane, s), row_frag(Qt, 32 * it, F.lane, s), pa);
                        const int i_ = 32 * it + (F.lane & 31);
#pragma unroll
                        for (int s = 0; s < 2; ++s) { unsigned w4[4];
#pragma unroll
                            for (int u = 0; u < 4; ++u) { const int r0 = 8 * s + 2 * u, j0 = 32 * jt + (r0 & 3) + 8 * (r0 >> 2) + 4 * (F.lane >> 5);
                                const bool ok0 = dir ? (j0 >= i_) : (j0 <= i_), ok1 = dir ? (j0 + 1 >= i_) : (j0 + 1 <= i_);
                                w4[u] = pk2(ok0 ? pa[r0] : 0.f, ok1 ? pa[r0 + 1] : 0.f); }
                            acc[t] = MFMA32(__builtin_bit_cast(bf16x8, (v4u){w4[0], w4[1], w4[2], w4[3]}), vpm[jt][s], acc[t]); }
                    }
                }
#pragma unroll
                for (int s = 0; s < 8; ++s) acc[t] = MFMA32(row_frag(Qd, 32 * it, F.lane, s), sfr[s], acc[t]);
            }
            __syncthreads();
        }
#pragma unroll
        for (int t = 0; t < NIT; ++t) { const int it = it0 + t;
            LAS float* ob = Ost + (32 * it + 4 * (F.lane >> 5)) * OLD + 32 * et + (F.lane & 31);
#pragma unroll
            for (int r = 0; r < 16; ++r) ob[((r & 3) + 8 * (r >> 2)) * OLD] = acc[t][r]; }
        if (item + F.G < nitems) P2_PREFETCH(item + F.G);
        constexpr int NTK = 64 * (DV / 8) / (NWAVES * 64);
        v4u graw[NTK];
#pragma unroll
        for (int t = 0; t < NTK; ++t) { const int i2 = F.tid + t * NWAVES * 64, m = i2 / (DV / 8), ch = i2 % (DV / 8); graw[t] = *(const GAS v4u*)(P.sg + (row0 + m) * D + h * DV + ch * 8); }
        __syncthreads();
#pragma unroll
        for (int t = 0; t < NTK; ++t) { const int i2 = F.tid + t * NWAVES * 64, m = i2 / (DV / 8), ch = i2 % (DV / 8);
            const f32x4 o0 = *(const LAS f32x4*)(Ost + m * OLD + ch * 8), o1 = *(const LAS f32x4*)(Ost + m * OLD + ch * 8 + 4);
            float ss = (o0.x * o0.x + o0.y * o0.y) + (o0.z * o0.z + o0.w * o0.w) + (o1.x * o1.x + o1.y * o1.y) + (o1.z * o1.z + o1.w * o1.w);
            ss = row_sum16(ss);
            if (DV == 256) ss += __shfl_xor(ss, 16);
            const float rstd = rsqrtf(ss * (1.f / DV) + EPS);
            float gf[8]; unpack8(graw[t], gf);
            v4u o; o.x = hwpk2(o0.x * rstd * gf[0], o0.y * rstd * gf[1]); o.y = hwpk2(o0.z * rstd * gf[2], o0.w * rstd * gf[3]); o.z = hwpk2(o1.x * rstd * gf[4], o1.y * rstd * gf[5]); o.w = hwpk2(o1.z * rstd * gf[6], o1.w * rstd * gf[7]);
            *(GAS v4u*)(P.y + (row0 + m) * P.ldy + P.ycol0 + h * DV + ch * 8) = o; }
        __syncthreads();
    }
}

#undef P2_PREFETCH
template <int PASS>
__device__ __forceinline__ void lru_pass(const Frame& F, const Args& A) {
    LAS float* xc = (LAS float*)F.lds;
    LAS unsigned char* Ximg = F.lds + 32768;
    LAS f32x2* AU = (LAS f32x2*)(F.lds + 49152);
    LAS float* rec = (LAS float*)(F.lds + 114688);
    LAS float* sagg = (LAS float*)(F.lds + 147456);
    LAS float* cw = (LAS float*)(F.lds + 151552);
    const bf16* XL = (const bf16*)(F.ws + WS_A + A_XL);
    const bf16* GX = (const bf16*)(F.ws + WS_A + A_GX);
    bf16* Y0 = (bf16*)(F.ws + WS_B + B_Y);
    float* agg = (float*)(F.ws + WS_LRU);
    const bf16* Wl = (const bf16*)(F.ws + WS_W_LRU);
    const int hh = F.vcu >> 5, li = F.vcu & 31, NPAIR = NB * NCH;
    if (F.G != 256) return;
    const int it = F.wave & 1, et = F.wave >> 1;
    const int e_l = 32 * et + (F.lane & 31);
    const int sch = F.tid & 127, sseg = F.tid >> 7;
    for (int i = F.tid; i < 5 * 128; i += NWAVES * 64) { const int j = i >> 7, ch = i & 127; cw[i] = j < 4 ? A.in[I_CONVW][j * D + hh * 128 + ch] : A.in[I_CONVB][hh * 128 + ch]; }
    float gba[2], gbi[2], gsp[2];
#pragma unroll
    for (int dir = 0; dir < 2; ++dir) { const int chn = hh * 128 + e_l; gba[dir] = A.in[I_LRUBA][dir * D + chn]; gbi[dir] = A.in[I_LRUBI][dir * D + chn]; gsp[dir] = log1pf(expf(-A.in[I_LRULAM][dir * D + chn])); }
    v4u xr[2][4];
#define LRU_PREFETCH(q_) do { const int c_ = (q_) % NCH, b_ = (q_) / NCH, s0_ = c_ * 64, lo_ = c_ < 4 ? 0 : CTX, hi_ = c_ < 4 ? CTX : T; \
        _Pragma("unroll") for (int t = 0; t < 2; ++t) { const int i_ = F.tid + t * NWAVES * 64, m_ = i_ >> 4, ch_ = i_ & 15; \
            _Pragma("unroll") for (int j = 0; j < 4; ++j) { const int ss = s0_ + m_ + j - 2; \
                xr[t][j] = (ss >= lo_ && ss < hi_) ? *(const GAS v4u*)(XL + ((size_t)b_ * T + ss) * D + hh * 128 + ch_ * 8) : (v4u){0u, 0u, 0u, 0u}; } \
            } } while (0)
    if (li < NPAIR) LRU_PREFETCH(li);
    __syncthreads();
    for (int q = li; q < NPAIR; q += 32) {
        const int c = q % NCH, b = q / NCH, s0 = c * 64;
        const size_t rowb = (size_t)b * T;
#pragma unroll
        for (int t = 0; t < 2; ++t) { const int i = F.tid + t * NWAVES * 64, m = i >> 4, ch = i & 15;
            float acc8[8];
            { const f32x4 b0 = *(const LAS f32x4*)(cw + 4 * 128 + ch * 8), b1 = *(const LAS f32x4*)(cw + 4 * 128 + ch * 8 + 4);
              acc8[0] = b0.x; acc8[1] = b0.y; acc8[2] = b0.z; acc8[3] = b0.w; acc8[4] = b1.x; acc8[5] = b1.y; acc8[6] = b1.z; acc8[7] = b1.w; }
#pragma unroll
            for (int j = 0; j < 4; ++j) { const v4u w = xr[t][j];
                const f32x4 w0 = *(const LAS f32x4*)(cw + j * 128 + ch * 8), w1 = *(const LAS f32x4*)(cw + j * 128 + ch * 8 + 4);
                acc8[0] += w0.x * bflo(w.x); acc8[1] += w0.y * bfhi(w.x); acc8[2] += w0.z * bflo(w.y); acc8[3] += w0.w * bfhi(w.y);
                acc8[4] += w1.x * bflo(w.z); acc8[5] += w1.y * bfhi(w.z); acc8[6] += w1.z * bflo(w.w); acc8[7] += w1.w * bfhi(w.w); }
            *(LAS f32x4*)(xc + m * 128 + ch * 8) = (f32x4){acc8[0], acc8[1], acc8[2], acc8[3]};
            *(LAS f32x4*)(xc + m * 128 + ch * 8 + 4) = (f32x4){acc8[4], acc8[5], acc8[6], acc8[7]};
            *(LAS v4u*)(Ximg + off_b(m, ch)) = (v4u){hwpk2(acc8[0], acc8[1]), hwpk2(acc8[2], acc8[3]), hwpk2(acc8[4], acc8[5]), hwpk2(acc8[6], acc8[7])}; }
        v4u gxc[2]; float cinc[2] = {0.f, 0.f};
        if (PASS == 2) {
#pragma unroll
            for (int t = 0; t < 2; ++t) { const int i = F.tid + t * NWAVES * 64, m = i >> 4, ch = i & 15; gxc[t] = *(const GAS v4u*)(GX + (rowb + s0 + m) * D + hh * 128 + ch * 8); }
#pragma unroll
            for (int dir = 0; dir < 2; ++dir) cinc[dir] = agg[((((size_t)dir * NB + b) * NCH + c) * D + hh * 128 + sch) * 2 + 1]; }
        if (q + 32 < NPAIR) LRU_PREFETCH(q + 32);
        __syncthreads();
        float hf[16];
        unsigned afp[8];
#pragma unroll 1
        for (int dir = 0; dir < 2; ++dir) {
            bf16x8 wfa[8], wfi[8];
            { const bf16* wa = Wl + (size_t)((dir * 2 + 0) * 8 + hh) * 16384 + (size_t)et * 4096 + F.lane * 8;
              const bf16* wi = Wl + (size_t)((dir * 2 + 1) * 8 + hh) * 16384 + (size_t)et * 4096 + F.lane * 8;
#pragma unroll
              for (int s = 0; s < 8; ++s) { wfa[s] = *(const GAS bf16x8*)(wa + 512 * s); wfi[s] = *(const GAS bf16x8*)(wi + 512 * s); } }
            f32x16 pa = zero16(), pi = zero16();
#pragma unroll
            for (int s = 0; s < 8; ++s) { const bf16x8 xf = row_frag(Ximg, 32 * it, F.lane, s); pa = MFMA32(xf, wfa[s], pa); pi = MFMA32(xf, wfi[s], pi); }
            { const float ba = dir ? gba[1] : gba[0], bi = dir ? gbi[1] : gbi[0], sp = dir ? gsp[1] : gsp[0];
#pragma unroll
              for (int r = 0; r < 16; ++r) { const int m = 32 * it + (r & 3) + 8 * (r >> 2) + 4 * (F.lane >> 5);
                  const float rr = fsigm(pa[r] + ba), gi = fsigm(pi[r] + bi);
                  const float la = -8.f * rr * sp, av = fexp(la);
                  AU[m * 128 + e_l] = (f32x2){av, __builtin_amdgcn_sqrtf(1.f - av * av) * gi * xc[m * 128 + e_l]}; } }
            __syncthreads();
            const int sg = dir ? 3 - sseg : sseg;
            float hst = 0.f, ap = 1.f;
#pragma unroll
            for (int i = 0; i < 16; ++i) { const int p = sg * 16 + i, m = dir ? 63 - p : p; const f32x2 au = AU[m * 128 + sch]; hst = au.x * hst + au.y; ap *= au.x; }
            sagg[(sg * 128 + sch) * 2] = ap; sagg[(sg * 128 + sch) * 2 + 1] = hst;
            __syncthreads();
            if (PASS == 1 || PASS == 3) {
                if (sseg == 3) { float h2 = 0.f, a2 = 1.f;
#pragma unroll
                    for (int s2 = 0; s2 < 4; ++s2) { const float aa = sagg[(s2 * 128 + sch) * 2], hl = sagg[(s2 * 128 + sch) * 2 + 1]; h2 = aa * h2 + hl; a2 *= aa; }
                    float* ag = agg + ((((size_t)dir * NB + b) * NCH + c) * D + hh * 128 + sch) * 2;
                    *(GAS f32x2*)ag = (f32x2){a2, h2}; }
            }
            if (PASS >= 2) {
                if (PASS == 3 && dir == 1) {
#pragma unroll
                    for (int t = 0; t < 2; ++t) { const int i = F.tid + t * NWAVES * 64, m = i >> 4, ch = i & 15; gxc[t] = *(const GAS v4u*)(GX + (rowb + s0 + m) * D + hh * 128 + ch * 8); } }
                float hin = PASS == 2 ? (dir ? cinc[1] : cinc[0]) : 0.f, apin = 1.f;
#pragma unroll
                for (int s2 = 0; s2 < 3; ++s2) if (s2 < sg) { const float aa = sagg[(s2 * 128 + sch) * 2]; hin = aa * hin + sagg[(s2 * 128 + sch) * 2 + 1]; apin *= aa; }
                if (dir == 0) { float ae = 0.f;
#pragma unroll
                    for (int i = 0; i < 16; ++i) { const int m = sseg * 16 + i; const f32x2 au = AU[m * 128 + sch]; hin = au.x * hin + au.y; hf[i] = hin;
                        if (PASS == 3) { apin *= au.x; if (i & 1) afp[i >> 1] = hwpk2(ae, apin); else ae = apin; } }
                } else {
#pragma unroll
                    for (int i = 0; i < 16; ++i) { const int m = sseg * 16 + 15 - i; const f32x2 au = AU[m * 128 + sch]; hin = au.x * hin + au.y; rec[m * 128 + sch] = hf[15 - i] + hin;
                        if (PASS == 3) { apin *= au.x; const unsigned fb = ((15 - i) & 1) ? (afp[(15 - i) >> 1] >> 16) : (afp[(15 - i) >> 1] & 0xffffu);
                            ((LAS unsigned*)xc)[m * 128 + sch] = fb | ((unsigned)hwbf(apin) << 16); } }
                }
            }
            __syncthreads();
        }
        if (PASS >= 2) {
#pragma unroll
            for (int t = 0; t < 2; ++t) { const int i = F.tid + t * NWAVES * 64, m = i >> 4, ch = i & 15, c0 = hh * 128 + ch * 8;
                const f32x4 r0 = *(LAS f32x4*)(rec + m * 128 + ch * 8), r1 = *(LAS f32x4*)(rec + m * 128 + ch * 8 + 4);
                v4u o;
                const v4u g = gxc[t];
                o.x = hwpk2(bflo(g.x) * r0.x, bfhi(g.x) * r0.y); o.y = hwpk2(bflo(g.y) * r0.z, bfhi(g.y) * r0.w); o.z = hwpk2(bflo(g.z) * r1.x, bfhi(g.z) * r1.y); o.w = hwpk2(bflo(g.w) * r1.z, bfhi(g.w) * r1.w);
                if (PASS == 3) { const v4u p0 = *(const LAS v4u*)((LAS unsigned*)xc + m * 128 + ch * 8), p1 = *(const LAS v4u*)((LAS unsigned*)xc + m * 128 + ch * 8 + 4);
                    const size_t po = ((size_t)((c >= 34 ? c - 34 : c) * 64 + m)) * D + c0; const int hf_ = c >= 34 ? 1 : 0;
                    *(GAS v4u*)((bf16*)(F.ws + lru_piece((b * 2 + 0) * 2 + hf_)) + po) = (v4u){hwpk2(bflo(g.x) * bflo(p0.x), bfhi(g.x) * bflo(p0.y)), hwpk2(bflo(g.y) * bflo(p0.z), bfhi(g.y) * bflo(p0.w)), hwpk2(bflo(g.z) * bflo(p1.x), bfhi(g.z) * bflo(p1.y)), hwpk2(bflo(g.w) * bflo(p1.z), bfhi(g.w) * bflo(p1.w))};
                    *(GAS v4u*)((bf16*)(F.ws + lru_piece((b * 2 + 1) * 2 + hf_)) + po) = (v4u){hwpk2(bflo(g.x) * bfhi(p0.x), bfhi(g.x) * bfhi(p0.y)), hwpk2(bflo(g.y) * bfhi(p0.z), bfhi(g.y) * bfhi(p0.w)), hwpk2(bflo(g.z) * bfhi(p1.x), bfhi(g.z) * bfhi(p1.y)), hwpk2(bflo(g.w) * bfhi(p1.z), bfhi(g.w) * bfhi(p1.w))}; }
                *(GAS v4u*)(Y0 + (rowb + s0 + m) * (2 * D) + c0) = o; }
            __syncthreads();
        }
    }
#undef LRU_PREFETCH
}
struct LruFixIn { v4u hs, af, ab, cf, cb; };
__device__ __forceinline__ void lru_fix_load(const Frame& F, int i, LruFixIn& L) {
    const bf16* Y0 = (const bf16*)(F.ws + WS_B + B_Y); const bf16* cc = (const bf16*)(F.ws + WS_TKE);
    const int row = i >> 7, c0 = (i & 127) * 8, b = row / T, s = row - b * T, c = s >> 6, m = s & 63, hf_ = c >= 34 ? 1 : 0;
    const size_t po = ((size_t)((c - 34 * hf_) * 64 + m)) * D + c0;
    L.hs = *(const GAS v4u*)(Y0 + (size_t)row * (2 * D) + c0);
    L.af = *(const GAS v4u*)((const bf16*)(F.ws + lru_piece((b * 2 + 0) * 2 + hf_)) + po); L.ab = *(const GAS v4u*)((const bf16*)(F.ws + lru_piece((b * 2 + 1) * 2 + hf_)) + po);
    L.cf = *(const GAS v4u*)(cc + (((size_t)0 * NB + b) * NCH + c) * D + c0); L.cb = *(const GAS v4u*)(cc + (((size_t)1 * NB + b) * NCH + c) * D + c0);
}
__device__ __forceinline__ void lru_fix_store(const Frame& F, int i, const LruFixIn& L) {
    bf16* Y0 = (bf16*)(F.ws + WS_B + B_Y);
    const int row = i >> 7, c0 = (i & 127) * 8;
    float y[8];
    const unsigned hw[4] = {L.hs.x, L.hs.y, L.hs.z, L.hs.w}, fw[4] = {L.af.x, L.af.y, L.af.z, L.af.w}, bw[4] = {L.ab.x, L.ab.y, L.ab.z, L.ab.w}, cfw[4] = {L.cf.x, L.cf.y, L.cf.z, L.cf.w}, cbw[4] = {L.cb.x, L.cb.y, L.cb.z, L.cb.w};
#pragma unroll
    for (int j = 0; j < 4; ++j) {
        y[2 * j] = bflo(hw[j]) + bflo(fw[j]) * bflo(cfw[j]) + bflo(bw[j]) * bflo(cbw[j]);
        y[2 * j + 1] = bfhi(hw[j]) + bfhi(fw[j]) * bfhi(cfw[j]) + bfhi(bw[j]) * bfhi(cbw[j]); }
    *(GAS v4u*)(Y0 + (size_t)row * (2 * D) + c0) = (v4u){hwpk2(y[0], y[1]), hwpk2(y[2], y[3]), hwpk2(y[4], y[5]), hwpk2(y[6], y[7])};
}
__device__ __forceinline__ void lru_fix(const Frame& F, int v0) {
    constexpr int NQ = R / 4;
    int q0, q1, qs;
    if (F.G == 256) { if (v0 < 64) { q0 = v0 * 8; q1 = q0 + 8; } else { q0 = 512 + (v0 - 64) * 20; q1 = q0 + 20; } qs = 1; }
    else { q0 = F.vcu; q1 = NQ; qs = F.G; }
    for (int q = q0; q < q1; q += 2 * qs) {
        const int i0 = q * (NWAVES * 64) + F.tid, i1 = (q + qs) * (NWAVES * 64) + F.tid; const bool two = q + qs < q1;
        LruFixIn A0, A1;
        lru_fix_load(F, i0, A0);
        if (two) lru_fix_load(F, i1, A1);
        lru_fix_store(F, i0, A0);
        if (two) lru_fix_store(F, i1, A1);
    }
}
__device__ __forceinline__ void lru_scan(const Frame& F) {
    float* agg = (float*)(F.ws + WS_LRU);
    const int gt = F.vcu * NWAVES * 64 + F.tid;
    if (gt < 2 * NB * D) { const int chn = gt % D, b = (gt / D) % NB, dir = gt / (D * NB);
        float hst = 0.f;
#pragma unroll 1
        for (int c0 = 0; c0 < NCH; c0 += 17) {
            f32x2 av[17];
#pragma unroll
            for (int j = 0; j < 17; ++j) { const int cs = c0 + j, c = dir ? (cs < 4 ? 3 - cs : 71 - cs) : cs; av[j] = *(const GAS f32x2*)(agg + ((((size_t)dir * NB + b) * NCH + c) * D + chn) * 2); }
#pragma unroll
            for (int j = 0; j < 17; ++j) { const int cs = c0 + j, c = dir ? (cs < 4 ? 3 - cs : 71 - cs) : cs;
                agg[((((size_t)dir * NB + b) * NCH + c) * D + chn) * 2 + 1] = hst; ((bf16*)(F.ws + WS_TKE))[(((size_t)dir * NB + b) * NCH + c) * D + chn] = hwbf(hst); hst = av[j].x * hst + av[j].y; } } }
}

constexpr size_t A_DEC = A_KV + KV_BYTES;
static_assert(A_DEC + (size_t)2 * 64 * NCH * 128 * 4 <= AREA_A_BYTES, "dec / eref overlay");
__device__ __forceinline__ ChunkP gla_params(const Frame& F, const Args& A) {
    ChunkP P;
    unsigned char* a = F.ws + WS_A;
    P.q = (const bf16*)(a + A_Q); P.ldq = 512; P.k = (const bf16*)(a + A_K); P.ldk = 512; P.v = (const bf16*)(a + A_V); P.ldv = D;
    P.alr = (const f16b*)(a + A_ALR); P.wa2 = A.in[I_GLAWA2]; P.gba = A.in[I_GLABA]; P.z[0] = nullptr; P.z[1] = nullptr; P.lbl = nullptr;
    P.sg = (const bf16*)(a + A_SG); P.y = (bf16*)(F.ws + WS_B + B_Y); P.ldy = 2 * D; P.ycol0 = D;
    P.kv = (bf16*)(a + A_KV); P.dec = (float*)(a + A_DEC);
    return P;
}
__device__ __forceinline__ int lru_light_first(const Frame& F) { return (F.G == 256) ? (((F.vcu & 31) >= 16 ? 0 : 128) + 16 * (F.vcu >> 5) + (F.vcu & 15)) : F.vcu; }
#define OPAQUE_TID(F) asm volatile("" : "+v"(F.tid), "+v"(F.lane))
__device__ __forceinline__ void p3_mix0_pass1(Frame& F, const Args& A) { lru_pass<MK_DEBUG ? 1 : 3>(F, A); const ChunkP P = gla_params(F, A); chunk_pass1<256, false>(F, P, 4, lru_light_first(F)); }
__device__ __forceinline__ void p4_mix0_scan(Frame& F, const Args& A) { const ChunkP P = gla_params(F, A); chunk_scan(F, P.kv, P.dec, 32, 256); lru_scan(F); }
__device__ __forceinline__ void p5_mix0_pass2(Frame& F, const Args& A) { if (MK_DEBUG) lru_pass<2>(F, A); else lru_fix(F, lru_light_first(F)); const ChunkP P = gla_params(F, A); chunk_pass2<256, false>(F, P, 4, 0, lru_light_first(F)); }

struct EpiPlain {
    bf16* dst; int ld;
    __device__ __forceinline__ bool full(const pg8::Unit&) const { return true; }
    __device__ __forceinline__ void operator()(const f32x4 (&acc)[2][2][4][2], const pg8::Unit& u, int wr, int wc, int fr, int fq) const {
        store_tile16<0, false>(acc, dst + u.pn * 256, ld, u.arow0, wr, wc, fr, fq, 1.f);
    }
};
__device__ __forceinline__ bf16* x1_row(const Frame& F, int row) { return (bf16*)(F.ws + WS_A + 6 * RD2) + (size_t)row * D; }
__device__ __forceinline__ bf16* x2_row(const Frame& F, int row) { const int b = row / T, s = row - b * T - CTX;
    return (bf16*)(b < 3 ? F.ws + WS_A + A_FREE + (size_t)b * ((size_t)SEQ * D * 2) : F.ws + WS_B + 2 * RD2) + (size_t)s * D; }
static_assert(A_FREE + 3 * (size_t)SEQ * D * 2 <= AREA_A_BYTES && 2 * RD2 + (size_t)SEQ * D * 2 <= AREA_B_BYTES && 7 * RD2 <= AREA_A_BYTES && 6 * RD2 >= A_H8 + (size_t)R * D, "residual copies");
__device__ __forceinline__ int perm_row(int row) { const int b = row / T, s = row - b * T; if (s < CTX) return row; const int t = s - CTX; return b * T + CTX + (t & 63) * 64 + (t >> 6); }

__device__ __forceinline__ void moe_weights(const Frame& F, const Args& A, int layer, int worker, int nworkers, int e_lo = 0, int e_hi = 65) {
    LAS float* scr = (LAS float*)(F.lds + F.wave * 16384);
    const int gw = worker * NWAVES + F.wave, NGW = nworkers * NWAVES;
    const bool own = (layer == 1) && !MK_DEBUG;
    unsigned char* W1t = own ? F.ws + WS_W1T1 : F.ws + WS_A + A_W1T; unsigned char* W2t = own ? F.ws + WS_W2T1 : F.ws + WS_W2T;
    int itb = 0;
    for (int e = e_lo; e < e_hi; ++e) {
        const float* wg = e < NE ? A.in[I_WG] + ((size_t)layer * NE + e) * D * FF : A.in[I_WSG] + (size_t)layer * D * FF;
        const float* wu = e < NE ? A.in[I_WU] + ((size_t)layer * NE + e) * D * FF : A.in[I_WSU] + (size_t)layer * D * FF;
        const float* wd = e < NE ? A.in[I_WD] + ((size_t)layer * NE + e) * FF * D : A.in[I_WSD] + (size_t)layer * FF * D;
        transpose_matrix8(wg, D, FF, FF, W1t + (size_t)e * 512 * D, D, 8, scr, F.lane, gw, NGW, itb);
        transpose_matrix8(wu, D, FF, FF, W1t + (size_t)e * 512 * D + 4 * D, D, 8, scr, F.lane, gw, NGW, itb);
        transpose_matrix8(wd, FF, D, D, W2t + (size_t)e * D * FF, FF, 4, scr, F.lane, gw, NGW, itb);
    }
}

__device__ __forceinline__ void p6_outproj0(Frame& F, const Args& A) {
    SchedPlain S{(const bf16*)(F.ws + WS_B + B_Y), (const bf16*)(F.ws + WS_W_OUT0), 2 * D, R / 256, D / 256, F.G, (int)blockIdx.x, 0};
    EpiPlain E{(bf16*)(F.ws + WS_A + A_O), D};
    pg8::gemm_phase<EpiPlain, SchedPlain>(F.lds, 2 * D, S, E);
    if (F.G == 256 && blockIdx.x >= 16) { __syncthreads(); moe_weights(F, A, 0, (int)blockIdx.x - 16, 240); }
}

__device__ __forceinline__ void p2_tail(Frame& F, const Args& A) {
    if (!MK_DEBUG && F.G == 256 && blockIdx.x >= (68 * 21) % 256) { __syncthreads(); moe_weights(F, A, 1, (int)blockIdx.x - (68 * 21) % 256, 256 - (68 * 21) % 256, 0, 16); }
}
__device__ __forceinline__ void p12_tail(Frame& F, const Args& A) {
    if (!MK_DEBUG && F.G == 256 && blockIdx.x >= (68 * 20) % 256) { __syncthreads(); moe_weights(F, A, 1, (int)blockIdx.x - (68 * 20) % 256, 256 - (68 * 20) % 256, 42, 65); }
}
template <int LAYER>
__device__ __forceinline__ void post_mixer(Frame& F, const Args& A) {
    const int gw = F.vcu * NWAVES + F.wave, NGW = F.G * NWAVES;
    const float* Ml = (const float*)(F.ws + WS_MOD) + (size_t)LAYER * 5 * NMOD;
    const bf16* O = (const bf16*)(F.ws + WS_A + A_O);
    bf16* H = (bf16*)(F.ws + WS_A + A_H); bf16* HL = (bf16*)(F.ws + WS_A + A_HL);
    float* ctxb = (float*)(F.ws + WS_CTXB);
    const float* sx = LAYER == 0 ? A.in[I_X] : F.out; const float* sc = LAYER == 0 ? A.in[I_CTX] : ctxb;
    const float* pg = A.in[I_POSTG] + (LAYER * 2 + 0) * D; const float* g2 = A.in[I_PREG] + (LAYER * 2 + 1) * D;
    const int nrows = LAYER == 0 ? R : NB * SEQ;
    for (int i = gw; i < nrows; i += NGW) {
        const int row = LAYER == 0 ? i : (i / SEQ) * T + CTX + (i % SEQ);
        const float* m = Ml + (size_t)mod_row(row) * NMOD;
        f32x4 o[4], x[4], h[4];
        row_load_bf16(O + (size_t)(LAYER == 0 ? row : perm_row(row)) * D, F.lane, o);
        row_load_f32(row_src(sx, sc, row), F.lane, x);
        const float rstd_o = rsqrtf(row_ss(o) * (1.f / D) + EPS);
#pragma unroll
        for (int j = 0; j < 4; ++j) { const f32x4 gt = ((const GAS f32x4*)(m + 2 * D))[F.lane + 64 * j], pgv = ((const GAS f32x4*)pg)[F.lane + 64 * j];
            x[j] = x[j] + gt * (o[j] * rstd_o * pgv); ((GAS f32x4*)row_dst(F.out, ctxb, row))[F.lane + 64 * j] = x[j]; }
        const float rstd = rsqrtf(row_ss(x) * (1.f / D) + EPS);
        row_prenorm(x, rstd, g2, m + 4 * D, m + 3 * D, F.lane, h);
#pragma unroll
        for (int j = 0; j < 4; ++j) { v2u wh, wl; const unsigned a0 = f2bf(h[j].x), a1 = f2bf(h[j].y), a2 = f2bf(h[j].z), a3 = f2bf(h[j].w);
            wh.x = a0 | (a1 << 16); wh.y = a2 | (a3 << 16);
            wl.x = pk2(h[j].x - bf2f(a0), h[j].y - bf2f(a1)); wl.y = pk2(h[j].z - bf2f(a2), h[j].w - bf2f(a3));
            ((GAS v2u*)(H + (size_t)row * D))[F.lane + 64 * j] = wh; ((GAS v2u*)(HL + (size_t)row * D))[F.lane + 64 * j] = wl;
            ((GAS unsigned*)(F.ws + WS_A + A_H8 + (size_t)row * D))[F.lane + 64 * j] = pk4f8(h[j].x, h[j].y, h[j].z, h[j].w); }
    }
}
__device__ __forceinline__ void p7_post(Frame& F, const Args& A, const int LAYER);

#define MFMA16(a, b, c) __builtin_amdgcn_mfma_f32_16x16x32_bf16((a), (b), (c), 0, 0, 0)
__device__ __forceinline__ void p7_post_route(Frame& F, const Args& A, const int LAYER) {
    constexpr int RS = 2064;
    LAS unsigned char* Ah = F.lds;
    LAS unsigned char* Al = F.lds + 32 * RS;
    LAS float* Lg = (LAS float*)(F.lds + 132096);
    LAS unsigned char* Ks = F.lds + 140288;
    LAS unsigned long long* selm = (LAS unsigned long long*)(F.lds + 142336);
    const float* Ml = (const float*)(F.ws + WS_MOD) + (size_t)LAYER * 5 * NMOD;
    const bf16* O = (const bf16*)(F.ws + WS_A + A_O);
    float* ctxb = (float*)(F.ws + WS_CTXB);
    const float* sx = LAYER == 0 ? A.in[I_X] : F.out; const float* sc = LAYER == 0 ? A.in[I_CTX] : ctxb;
    const float* pg = A.in[I_POSTG] + (LAYER * 2 + 0) * D; const float* g2 = A.in[I_PREG] + (LAYER * 2 + 1) * D;
    const bf16* Rh = (const bf16*)(F.ws + WS_W_RT) + (size_t)LAYER * 2 * NE * D; const bf16* Rl = Rh + (size_t)NE * D;
    int* tke = (int*)(F.ws + WS_TKE); int* tkp = (int*)(F.ws + WS_TKP); float* tkw = (float*)(F.ws + WS_TKW); int* list = (int*)(F.ws + WS_LIST);
    int* cnt = (int*)(F.ws + WS_CTL) + CW_CNT + LAYER * 64;
    const int ngroups = LAYER == 0 ? R / 32 : NB * SEQ / 32;
    int lane_ = F.lane; asm volatile("" : "+v"(lane_));
    const int lane = lane_, kh = F.wave & 1, eq = F.wave >> 1;
    const float bias = A.in[I_MOEB][LAYER * NE + lane];
    const bf16* bh = Rh + (size_t)eq * 32 * 512 + lane * 8; const bf16* bl = Rl + (size_t)eq * 32 * 512 + lane * 8;
    const unsigned aoffs = (unsigned)((lane & 15) * RS + (lane >> 4) * 16);
    LAS float* mA = (LAS float*)(F.lds + 142592); LAS float* mB = mA + D; LAS float* mC = mB + D;
#define P7_MODVEC(g_) do { const int r0_ = LAYER == 0 ? (g_) * 32 : ((g_) / 128) * T + CTX + ((g_) % 128) * 32; const float* m_ = Ml + (size_t)mod_row(r0_) * NMOD; \
        for (int i_ = F.tid; i_ < D; i_ += NWAVES * 64) { mA[i_] = m_[2 * D + i_] * pg[i_]; mB[i_] = g2[i_] * (1.0f + m_[4 * D + i_]); mC[i_] = m_[3 * D + i_]; } } while (0)
    if (F.vcu < ngroups) P7_MODVEC(F.vcu);
    __syncthreads();
    for (int g = F.vcu; g < ngroups; g += F.G) {
        const int row0 = LAYER == 0 ? g * 32 : (g / 128) * T + CTX + (g % 128) * 32;
#pragma unroll 2
        for (int rr = 0; rr < 4; ++rr) { const int r = F.wave + 8 * rr, row = row0 + r;
            f32x4 o[4], x[4];
            row_load_bf16(O + (size_t)(LAYER == 0 ? row : perm_row(row)) * D, lane, o);
            if (LAYER == 0) row_load_f32(row_src(sx, sc, row), lane, x); else row_load_bf16(x2_row(F, row), lane, x);
            const float rstd_o = rsqrtf(row_ss(o) * (1.f / D) + EPS);
#pragma unroll
            for (int j = 0; j < 4; ++j) x[j] = x[j] + *(const LAS f32x4*)(mA + 4 * (lane + 64 * j)) * (o[j] * rstd_o);
            row_store_bf16(x1_row(F, row), lane, x);
            const float rstd = rsqrtf(row_ss(x) * (1.f / D) + EPS);
#pragma unroll
            for (int j = 0; j < 4; ++j) {
                const f32x4 h = x[j] * rstd * *(const LAS f32x4*)(mB + 4 * (lane + 64 * j)) + *(const LAS f32x4*)(mC + 4 * (lane + 64 * j));
                v2u wh, wl; const unsigned a0 = f2bf(h.x), a1 = f2bf(h.y), a2 = f2bf(h.z), a3 = f2bf(h.w);
                wh.x = a0 | (a1 << 16); wh.y = a2 | (a3 << 16);
                wl.x = pk2(h.x - bf2f(a0), h.y - bf2f(a1)); wl.y = pk2(h.z - bf2f(a2), h.w - bf2f(a3));
                *(LAS v2u*)(Ah + r * RS + (4 * lane + 256 * j) * 2) = wh; *(LAS v2u*)(Al + r * RS + (4 * lane + 256 * j) * 2) = wl;
                ((GAS unsigned*)(F.ws + WS_A + A_H8 + (size_t)row * D))[lane + 64 * j] = pk4f8(h.x, h.y, h.z, h.w); }
        }
        __syncthreads();
        f32x4 acc0 = {0.f, 0.f, 0.f, 0.f}, acc1 = {0.f, 0.f, 0.f, 0.f};
#pragma unroll 1
        for (int kb = 0; kb < 2; ++kb) {
            bf16x8 fh[8], fl[8];
#pragma unroll
            for (int s = 0; s < 8; ++s) { fh[s] = *(const GAS bf16x8*)(bh + (size_t)(kh * 16 + kb * 8 + s) * 512); fl[s] = *(const GAS bf16x8*)(bl + (size_t)(kh * 16 + kb * 8 + s) * 512); }
#pragma unroll
            for (int s = 0; s < 8; ++s) { const int ks = kh * 16 + kb * 8 + s;
                const bf16x8 ah0 = *(const LAS bf16x8*)(Ah + aoffs + ks * 64), al0 = *(const LAS bf16x8*)(Al + aoffs + ks * 64);
                const bf16x8 ah1 = *(const LAS bf16x8*)(Ah + aoffs + 16 * RS + ks * 64), al1 = *(const LAS bf16x8*)(Al + aoffs + 16 * RS + ks * 64);
                acc0 = MFMA16(ah0, fh[s], acc0); acc1 = MFMA16(ah1, fh[s], acc1); acc0 = MFMA16(al0, fh[s], acc0); acc1 = MFMA16(al1, fh[s], acc1); acc0 = MFMA16(ah0, fl[s], acc0); acc1 = MFMA16(ah1, fl[s], acc1); }
        }
        if (kh == 0) {
#pragma unroll
            for (int r = 0; r < 4; ++r) { Lg[((lane >> 4) * 4 + r) * 64 + 16 * eq + (lane & 15)] = acc0[r]; Lg[(16 + (lane >> 4) * 4 + r) * 64 + 16 * eq + (lane & 15)] = acc1[r]; } }
        __syncthreads();
        if (kh == 1) {
#pragma unroll
            for (int r = 0; r < 4; ++r) { Lg[((lane >> 4) * 4 + r) * 64 + 16 * eq + (lane & 15)] += acc0[r]; Lg[(16 + (lane >> 4) * 4 + r) * 64 + 16 * eq + (lane & 15)] += acc1[r]; } }
        __syncthreads();
        for (int t4 = 0; t4 < 4; ++t4) { const int tk = F.wave * 4 + t4;
            float lgv = Lg[tk * 64 + lane]; lgv = (lgv == lgv) ? lgv : 0.f;
            const float aff = 1.f / (1.f + expf(-lgv)), bs = aff + bias;
            int rk = 0;
#pragma unroll
            for (int j = 0; j < 8; ++j) { const int o = (lane & ~7) + j; const float xv = __shfl(bs, o); rk += (xv > bs || (xv == bs && o < lane)) ? 1 : 0; }
            float gs = rk < 2 ? bs : 0.f;
            gs += __shfl_xor(gs, 1); gs += __shfl_xor(gs, 2); gs += __shfl_xor(gs, 4);
            int grk = 0; const int gi = lane >> 3;
#pragma unroll
            for (int j = 0; j < 8; ++j) { const float xv = __builtin_bit_cast(float, __builtin_amdgcn_readlane(__builtin_bit_cast(int, gs), j * 8)); grk += (xv > gs || (xv == gs && j < gi)) ? 1 : 0; }
            const bool keep = grk < 4;
            const float mv = keep ? bs : -INFINITY;
            unsigned long long kb_ = __ballot(keep);
            int erk = 0;
#pragma unroll
            for (int gq = 0; gq < 8; ++gq) {
                if ((kb_ >> (8 * gq)) & 1ull) {
#pragma unroll
                    for (int j = 0; j < 8; ++j) { const int src = 8 * gq + j;
                        const float xv = __builtin_bit_cast(float, __builtin_amdgcn_readlane(__builtin_bit_cast(int, mv), src)); erk += (xv > mv || (xv == mv && src < lane)) ? 1 : 0; } } }
            const bool sel = keep && erk < TOPK;
            const float ssum = wsum(sel ? aff : 0.f);
            Lg[tk * 64 + lane] = sel ? 2.5f * aff / ssum : 0.f;
            Ks[tk * 64 + lane] = (unsigned char)erk;
            const unsigned long long bm = __ballot(sel);
            if (lane == 0) selm[tk] = bm;
        }
        __syncthreads();
        if (F.wave == 0) {
            unsigned mk = 0u;
#pragma unroll
            for (int tk = 0; tk < 32; ++tk) mk |= (unsigned)((selm[tk] >> lane) & 1ull) << tk;
            const int ne = __builtin_popcount(mk);
            int base = 0;
            if (ne) base = atomicAdd(&cnt[lane], ne);
            int rank = 0;
            while (mk) { const int tk = __builtin_ctz(mk); mk &= mk - 1u;
                const int row = row0 + tk, k = Ks[tk * 64 + lane], pos = base + rank; ++rank;
                list[(size_t)lane * R + pos] = row * 8 + k;
                tke[(size_t)row * 8 + k] = lane; tkp[(size_t)row * 8 + k] = pos; tkw[(size_t)row * 8 + k] = Lg[tk * 64 + lane]; }
        }
        if (g + F.G < ngroups) P7_MODVEC(g + F.G);
        __syncthreads();
    }
#undef P7_MODVEC
}

__device__ __forceinline__ void p7_post(Frame& F, const Args& A, const int LAYER) { p7_post_route(F, A, LAYER); if ((LAYER == 1 && MK_DEBUG) || F.G != 256) { __syncthreads(); moe_weights(F, A, LAYER, F.vcu, F.G); } }

template <int LAYER>
__device__ __forceinline__ void moe_tile_table(const Frame& F, LAS int* tb) {
    if (F.wave == 0) {
        const int* cnt = (const int*)(F.ws + WS_CTL) + CW_CNT + LAYER * 64;
        const int n = __hip_atomic_load(cnt + F.lane, RLX_AGENT), tiles = (n + 255) >> 8;
        int incl = tiles;
#pragma unroll
        for (int off = 1; off < 64; off <<= 1) { const int v = __shfl_up(incl, off); incl += (F.lane >= off) ? v : 0; }
        tb[F.lane] = incl - tiles; tb[NE + 2 + F.lane] = n;
        if (F.lane == 63) { tb[NE] = incl; tb[NE + 1] = incl + (LAYER == 0 ? R : NB * SEQ) / 256; } }
    __syncthreads();
}
template <int LAYER, int NPN, bool GATHER>
struct SchedMoe {
    const LAS int* tb; const int* cnt; const int* list; const char* Ab; const char* Bb; int K, G, c;
    __device__ __forceinline__ bool next(int i, pg8::Unit& u) const {
        const int nU = tb[NE + 1] * NPN; const long L = (long)i * G + c; if (L >= nU) return false;
        const int wgid = pg8::xcd_remap((int)L, nU), rt = wgid / NPN;
        int lo = 0, hi = NE;
        while (lo < hi) { const int mid = (lo + hi + 1) >> 1; if (tb[mid] <= rt) lo = mid; else hi = mid - 1; }
        u.e = lo; u.pm = rt - tb[lo]; u.pn = wgid % NPN; u.arow0 = rt * 256;
        return true;
    }
    __device__ __forceinline__ void a_offs(const pg8::Unit& u, unsigned (&v)[2][2], int tid) const {
        const int n_e = (GATHER && u.e < NE) ? tb[NE + 2 + u.e] : 0;
#pragma unroll
        for (int i = 0; i < 2; ++i) { int R_, C_; pg8::stage_rc(tid * 16 + i * 8192, R_, C_);
#pragma unroll
            for (int h = 0; h < 2; ++h) {
                if (GATHER) { const int pos = u.pm * 256 + h * 128 + R_; int row;
                    if (u.e < NE) row = pos < n_e ? (list[(size_t)u.e * R + pos] >> 3) : 0;
                    else row = LAYER == 0 ? pos : (pos / SEQ) * T + CTX + (pos % SEQ);
                    v[h][i] = (unsigned)(row * K + C_) * 2u; }
                else v[h][i] = (unsigned)((u.arow0 + h * 128 + R_) * K + C_) * 2u; } }
    }
    __device__ __forceinline__ const char* a_base() const { return Ab; }
    __device__ __forceinline__ const char* b_base(const pg8::Unit& u) const { return Bb + ((size_t)u.e * (NPN == 2 ? 512 : 1024) + (size_t)u.pn * 256) * K * 2; }
};
struct EpiSwiglu {
    unsigned char* act; LAS unsigned char* scr; int tid;
    __device__ __forceinline__ bool full(const pg8::Unit&) const { return true; }
    __device__ __forceinline__ void operator()(const f32x4 (&acc)[2][2][4][2], const pg8::Unit& u, int wr, int wc, int fr, int fq) const {
#pragma unroll
        for (int ai = 0; ai < 2; ++ai) {
#pragma unroll
            for (int m = 0; m < 4; ++m) { const int row = wr * 64 + m * 16 + fr;
#pragma unroll
                for (int bj = 0; bj < 2; ++bj) { const f32x4 g = acc[ai][bj][m][0], up = acc[ai][bj][m][1];
                    *(LAS unsigned*)(scr + row * 128 + (((bj * 4 + wc) ^ (fr & 7)) * 16) + fq * 4) = pk4f8(fsilu(g[0]) * up[0], fsilu(g[1]) * up[1], fsilu(g[2]) * up[2], fsilu(g[3]) * up[3]); } }
            __syncthreads();
#pragma unroll
            for (int j = 0; j < 2; ++j) { const int li = j * 512 + tid, R_ = li >> 3, p_ = li & 7;
                *(GAS v4u*)(act + (size_t)(u.arow0 + ai * 128 + R_) * FF + u.pn * 128 + p_ * 16) = *(const LAS v4u*)(scr + R_ * 128 + ((p_ ^ (R_ & 7)) * 16)); }
            __syncthreads();
        }
    }
};
template <int LAYER>
__device__ __forceinline__ void p9_gemm1(Frame& F, const Args& A) {
    LAS int* tb = (LAS int*)(F.lds + 132096);
    moe_tile_table<LAYER>(F, tb);
    SchedMoe<LAYER, 2, true> S{tb, (const int*)(F.ws + WS_CTL) + CW_CNT + LAYER * 64, (const int*)(F.ws + WS_LIST), (const char*)(F.ws + WS_A + A_H8), (const char*)((LAYER == 1 && !MK_DEBUG) ? F.ws + WS_W1T1 : F.ws + WS_A + A_W1T), D / 2, F.G, (int)blockIdx.x};
    EpiSwiglu E{F.ws + WS_B + B_ACT, F.lds + 133120, F.tid};
    int kk = D / 2; asm volatile("" : "+s"(kk));
    pg8::gemm_phase<EpiSwiglu, SchedMoe<LAYER, 2, true>, true>(F.lds, kk, S, E);
    if (LAYER == 0 && !MK_DEBUG && F.G == 256) {
        const int nU = tb[NE + 1] * 2, rem = nU % 256, nidle = rem ? 256 - rem : 0;
        __syncthreads();
        if (nidle >= 64) { if ((int)blockIdx.x >= rem) moe_weights(F, A, 1, (int)blockIdx.x - rem, nidle, 16, 42); }
        else moe_weights(F, A, 1, F.vcu, F.G, 16, 42); }
}
struct EpiPlain8 {
    unsigned char* dst; int ld; int abl;
    __device__ __forceinline__ bool full(const pg8::Unit&) const { return !(abl & 64); }
    __device__ __forceinline__ void operator()(const f32x4 (&acc)[2][2][4][2], const pg8::Unit& u, int wr, int wc, int fr, int fq) const {
        if (abl & 64) { f32x4 s = {0.f, 0.f, 0.f, 0.f};
#pragma unroll
            for (int ai = 0; ai < 2; ++ai)
#pragma unroll
                for (int bj = 0; bj < 2; ++bj)
#pragma unroll
                    for (int m = 0; m < 4; ++m) { s = s + acc[ai][bj][m][0]; s = s + acc[ai][bj][m][1]; }
            if (s[0] + s[1] + s[2] + s[3] == 12345.678f) dst[1] = 1; return; }
#pragma unroll
        for (int ai = 0; ai < 2; ++ai)
#pragma unroll
            for (int m = 0; m < 4; ++m) { unsigned char* rowp = dst + (size_t)(u.arow0 + ai * 128 + wr * 64 + m * 16 + fr) * ld + u.pn * 256 + wc * 32 + 8 * fq;
#pragma unroll
                for (int bj = 0; bj < 2; ++bj) { const f32x4 v0 = acc[ai][bj][m][0], v1 = acc[ai][bj][m][1];
                    *(GAS v2u*)(rowp + bj * 128) = (v2u){pk4f8(v0[0], v0[1], v0[2], v0[3]), pk4f8(v1[0], v1[1], v1[2], v1[3])}; } }
    }
};
template <int LAYER>
__device__ __forceinline__ void gemm2_astat(Frame& F, const LAS int* tb) {
    typedef int v8i __attribute__((ext_vector_type(8))); typedef int v4i __attribute__((ext_vector_type(4)));
    const unsigned char* ACT = F.ws + WS_B + B_ACT; const unsigned char* W2 = (LAYER == 1 && !MK_DEBUG) ? F.ws + WS_W2T1 : F.ws + WS_W2T; unsigned char* YD = F.ws + WS_A;
    const int tid = F.tid, wid = F.wave, lane = tid & 63, wr = wid >> 1, wc = wid & 1, fr = lane & 15, fq = lane >> 4;
    const int nrt = __builtin_amdgcn_readfirstlane(tb[NE + 1]);
    LAS unsigned char* OUT = F.lds + 65536;
    unsigned soff[4], ooff[4], olds[4];
#pragma unroll
    for (int j = 0; j < 4; ++j) { const int li = j * 512 + tid, rho = li >> 4, col = (rho & ~63) + 16 * ((rho & 15) >> 2) + 4 * ((rho >> 4) & 3) + (rho & 3), ch = (li & 15) ^ (rho & 15); soff[j] = (unsigned)(col * 256 + ch * 16);
        const int R_ = li >> 3, p_ = li & 7; ooff[j] = (unsigned)(R_ * D + p_ * 16); olds[j] = (unsigned)(R_ * 128 + ((p_ ^ (R_ & 7)) * 16)); }
    const unsigned ldsw = (unsigned)wid * 1024u;
    unsigned boff[2][2];
#pragma unroll
    for (int ks = 0; ks < 2; ++ks)
#pragma unroll
        for (int p = 0; p < 2; ++p) boff[ks][p] = (unsigned)((wc * 64 + fr) * 256 + (((ks * 8 + fq * 2 + p) ^ fr) * 16));
    const unsigned owr = (unsigned)((wr * 64 + fr) * 128), ochk = (unsigned)(wc * 4 + fq);
#define G2_STAGE(buf_, src_) do { _Pragma("unroll") for (int j_ = 0; j_ < 4; ++j_) __builtin_amdgcn_global_load_lds((const unsigned*)((src_) + soff[j_]), (LAS unsigned*)(F.lds + (buf_) * 32768 + j_ * 8192 + ldsw), 16, 0, 0); } while (0)
#define G2_STOREOUT(buf_, dst_) do { _Pragma("unroll") for (int j_ = 0; j_ < 4; ++j_) *(GAS v4u*)((dst_) + ooff[j_]) = *(const LAS v4u*)(OUT + (buf_) * 32768 + olds[j_]); } while (0)
    const unsigned NS = (unsigned)nrt * 8u, c2 = (F.G & 7) ? blockIdx.x : (blockIdx.x & 7u) * (unsigned)(F.G >> 3) + (blockIdx.x >> 3);
    const int g0 = (int)(c2 * NS / (unsigned)F.G), g1 = (int)((c2 + 1u) * NS / (unsigned)F.G);
    if (g0 >= g1) return;
    int rt = g0 >> 3, sb = g0 & 7; const int rt_last = (g1 - 1) >> 3;
    int e; { int lo = 0, hi = NE; while (lo < hi) { const int mid = (lo + hi + 1) >> 1; if (tb[mid] <= rt) lo = mid; else hi = mid - 1; } e = __builtin_amdgcn_readfirstlane(lo); }
    const unsigned char* wb = W2 + (size_t)e * (D * FF);
    G2_STAGE(0, wb + (size_t)sb * 128 * FF);
    int g = 0;
    unsigned char* yprev = YD;
    for (;;) {
        v8i At[4][2];
        { const unsigned char* ap = ACT + (size_t)(rt * 256 + wr * 64 + fr) * FF + fq * 32;
#pragma unroll
          for (int m = 0; m < 4; ++m)
#pragma unroll
              for (int ks = 0; ks < 2; ++ks) { const v4i lo_ = *(const GAS v4i*)(ap + m * 16 * FF + ks * 128), hi_ = *(const GAS v4i*)(ap + m * 16 * FF + ks * 128 + 16); At[m][ks] = __builtin_shufflevector(lo_, hi_, 0, 1, 2, 3, 4, 5, 6, 7); } }
        const bool has_next = rt < rt_last; const int se = has_next ? 8 : ((g1 - 1) & 7) + 1;
        int rtn = rt, en = e;
        if (has_next) { rtn = rt + 1; int lo = 0, hi = NE; while (lo < hi) { const int mid = (lo + hi + 1) >> 1; if (tb[mid] <= rtn) lo = mid; else hi = mid - 1; } en = __builtin_amdgcn_readfirstlane(lo); }
        const unsigned char* wbn = W2 + (size_t)en * (D * FF);
#pragma unroll 1
        for (int s = sb; s < se; ++s, ++g) {
            if (s == sb || g == 1) asm volatile("s_waitcnt vmcnt(0)" ::: "memory");
            else asm volatile("s_waitcnt vmcnt(4)" ::: "memory");
            __syncthreads();
            if (s + 1 < se) G2_STAGE((g + 1) & 1, wb + (size_t)(s + 1) * 128 * FF); else if (has_next) G2_STAGE((g + 1) & 1, wbn);
            const LAS unsigned char* bb = F.lds + (g & 1) * 32768;
            v8i Bt[2][4];
#pragma unroll
            for (int ks = 0; ks < 2; ++ks)
#pragma unroll
                for (int n = 0; n < 4; ++n) { const v4i lo_ = *(const LAS v4i*)(bb + boff[ks][0] + n * 4096), hi_ = *(const LAS v4i*)(bb + boff[ks][1] + n * 4096); Bt[ks][n] = __builtin_shufflevector(lo_, hi_, 0, 1, 2, 3, 4, 5, 6, 7); }
            LAS unsigned char* ob = OUT + (g & 1) * 32768 + owr + ((ochk ^ (unsigned)(fr & 7)) * 16);
            const f32x4 z4 = {0.f, 0.f, 0.f, 0.f};
            f32x4 pv[4] = {z4, z4, z4, z4};
#pragma unroll
            for (int m = 0; m < 4; ++m) {
                f32x4 c[4];
#pragma unroll
                for (int n = 0; n < 4; ++n) c[n] = __builtin_amdgcn_mfma_scale_f32_16x16x128_f8f6f4(Bt[0][n], At[m][0], z4, 0, 0, 0, 0x7C7C7C7C, 0, 0x7C7C7C7C);
#pragma unroll
                for (int n = 0; n < 4; ++n) c[n] = __builtin_amdgcn_mfma_scale_f32_16x16x128_f8f6f4(Bt[1][n], At[m][1], c[n], 0, 0, 0, 0x7C7C7C7C, 0, 0x7C7C7C7C);
                if (m > 0) *(LAS v4u*)(ob + (m - 1) * 2048) = (v4u){pk4f8(pv[0][0], pv[0][1], pv[0][2], pv[0][3]), pk4f8(pv[1][0], pv[1][1], pv[1][2], pv[1][3]), pk4f8(pv[2][0], pv[2][1], pv[2][2], pv[2][3]), pk4f8(pv[3][0], pv[3][1], pv[3][2], pv[3][3])};
                if (m > 0) {
#pragma unroll
                    for (int q_ = 0; q_ < 8; ++q_) { __builtin_amdgcn_sched_group_barrier(0x008, 1, 0); __builtin_amdgcn_sched_group_barrier(0x002, 3, 0); }
                }
#pragma unroll
                for (int n = 0; n < 4; ++n) pv[n] = c[n];
            }
            *(LAS v4u*)(ob + 3 * 2048) = (v4u){pk4f8(pv[0][0], pv[0][1], pv[0][2], pv[0][3]), pk4f8(pv[1][0], pv[1][1], pv[1][2], pv[1][3]), pk4f8(pv[2][0], pv[2][1], pv[2][2], pv[2][3]), pk4f8(pv[3][0], pv[3][1], pv[3][2], pv[3][3])};
            if (g > 0) G2_STOREOUT((g + 1) & 1, yprev);
            yprev = YD + (size_t)(rt * 256) * D + s * 128;
        }
        if (!has_next) break;
        rt = rtn; e = en; wb = wbn; sb = 0;
    }
    asm volatile("s_waitcnt vmcnt(0)" ::: "memory");
    __syncthreads();
    G2_STOREOUT((g + 1) & 1, yprev);
    asm volatile("s_waitcnt vmcnt(0)" ::: "memory");
    __syncthreads();
#undef G2_STAGE
#undef G2_STOREOUT
}
template <int LAYER>
__device__ __forceinline__ void p10_gemm2(Frame& F, const Args& A) {
    LAS int* tb = (LAS int*)(F.lds + 132096);
    moe_tile_table<LAYER>(F, tb);
    gemm2_astat<LAYER>(F, tb);
}
template <int LAYER>
__device__ __forceinline__ void p11_combine(Frame& F, const Args& A) {
    LAS int* tb = (LAS int*)(F.lds + 132096);
    moe_tile_table<LAYER>(F, tb);
    const int gw = F.vcu * NWAVES + F.wave, NGW = F.G * NWAVES;
    const float* Ml = (const float*)(F.ws + WS_MOD) + (size_t)LAYER * 5 * NMOD;
    const unsigned char* YD = F.ws + WS_A;
    const int* tke = (const int*)(F.ws + WS_TKE); const int* tkp = (const int*)(F.ws + WS_TKP); const float* tkw = (const float*)(F.ws + WS_TKW);
    float* ctxb = (float*)(F.ws + WS_CTXB);
    const float* pg = A.in[I_POSTG] + (LAYER * 2 + 1) * D;
    const int nrows = LAYER == 0 ? R : NB * SEQ;
    LAS float* mg = (LAS float*)F.lds; LAS float* mp = mg + 5 * D; LAS float* ms = mp + 5 * D;
    for (int i = F.tid; i < 5 * D; i += NWAVES * 64) { const int v = i >> 10, c = i & (D - 1); mg[i] = Ml[(size_t)v * NMOD + 5 * D + c] * pg[c];
        if (LAYER == 0) { const float* m1 = (const float*)(F.ws + WS_MOD) + (size_t)(5 + v) * NMOD; mp[i] = A.in[I_PREG][2 * D + c] * (1.0f + m1[1 * D + c]); ms[i] = m1[0 * D + c]; } }
    __syncthreads();
#pragma unroll 2
    for (int i = gw; i < nrows; i += NGW) {
        const int row = LAYER == 0 ? i : (i / SEQ) * T + CTX + (i % SEQ);
        const int v = mod_row(row);
        f32x4 f[4], y[4], x[4];
        row_load_f8(YD + ((size_t)tb[NE] * 256 + i) * D, F.lane, f);
#pragma unroll
        for (int k = 0; k < TOPK; ++k) { const int e = tke[(size_t)row * 8 + k], pos = tkp[(size_t)row * 8 + k]; const float w = tkw[(size_t)row * 8 + k];
            row_load_f8(YD + ((size_t)tb[e] * 256 + pos) * D, F.lane, y);
#pragma unroll
            for (int j = 0; j < 4; ++j) f[j] = f[j] + y[j] * w; }
        row_load_bf16(x1_row(F, row), F.lane, x);
        const float rstd_f = rsqrtf(row_ss(f) * (1.f / D) + EPS);
#pragma unroll
        for (int j = 0; j < 4; ++j) { const f32x4 gp = *(const LAS f32x4*)(mg + v * D + 4 * (F.lane + 64 * j));
            x[j] = x[j] + gp * (f[j] * rstd_f); if (LAYER == 1) ((GAS f32x4*)row_dst(F.out, ctxb, row))[F.lane + 64 * j] = x[j]; }
        if (LAYER == 0 && row - (row / T) * T >= CTX) row_store_bf16(x2_row(F, row), F.lane, x);
        if (LAYER == 0) {
            f32x4 h[4];
            const float rstd = rsqrtf(row_ss(x) * (1.f / D) + EPS);
#pragma unroll
            for (int j = 0; j < 4; ++j) h[j] = x[j] * rstd * *(const LAS f32x4*)(mp + v * D + 4 * (F.lane + 64 * j)) + *(const LAS f32x4*)(ms + v * D + 4 * (F.lane + 64 * j));
            row_store_bf16((bf16*)(F.ws + WS_B + B_H1) + (size_t)perm_row(row) * D, F.lane, h);
        }
    }
}

struct EpiIn1 {
    unsigned char* a;
    __device__ __forceinline__ bool full(const pg8::Unit&) const { return true; }
    __device__ __forceinline__ void operator()(const f32x4 (&acc)[2][2][4][2], const pg8::Unit& u, int wr, int wc, int fr, int fq) const {
        const int pn = u.pn, r0 = u.arow0;
        if (pn < 4) store_tile16<0, false>(acc, (bf16*)(a + A_Q1) + pn * 256, D, r0, wr, wc, fr, fq, 1.f);
        else if (pn < 8) store_tile16<0, true>(acc, (f16b*)(a + A_ZF) + (pn - 4) * 256, D, r0, wr, wc, fr, fq, 1.f);
        else if (pn < 12) store_tile16<0, true>(acc, (f16b*)(a + A_ZB) + (pn - 8) * 256, D, r0, wr, wc, fr, fq, 1.f);
        else if (pn < 16) store_tile16<0, false>(acc, (bf16*)(a + A_V1) + (pn - 12) * 256, D, r0, wr, wc, fr, fq, 1.f);
        else store_tile16<2, false>(acc, (bf16*)(a + A_SG1) + (pn - 16) * 256, D, r0, wr, wc, fr, fq, 1.f);
    }
};
__device__ __forceinline__ void p12_inproj1(Frame& F, const Args& A) {
    SchedPlain S{(const bf16*)(F.ws + WS_B + B_H1), (const bf16*)(F.ws + WS_W_IN1), D, R / 256, CC / 256, F.G, (int)blockIdx.x, 0};
    EpiIn1 E{F.ws + WS_A};
    pg8::gemm_phase<EpiIn1, SchedPlain>(F.lds, D, S, E);
    p12_tail(F, A);
}
__device__ __forceinline__ ChunkP hgrn_params(const Frame& F, const Args& A) {
    ChunkP P;
    unsigned char* a = F.ws + WS_A;
    P.q = (const bf16*)(a + A_Q1); P.ldq = D; P.k = nullptr; P.ldk = 0; P.v = (const bf16*)(a + A_V1); P.ldv = D;
    P.alr = nullptr; P.wa2 = nullptr; P.gba = nullptr; P.z[0] = (const f16b*)(a + A_ZF); P.z[1] = (const f16b*)(a + A_ZB); P.lbl = (const float*)(F.ws + WS_MOD + 245760);
    P.sg = (const bf16*)(a + A_SG1); P.y = (bf16*)(F.ws + WS_B + B_Y1); P.ldy = D; P.ycol0 = 0;
    P.kv = (bf16*)(a + A_KV); P.dec = (float*)(a + A_DEC);
    return P;
}
__device__ __forceinline__ void p13_mix1_pass1(Frame& F, const Args& A) { const ChunkP P = hgrn_params(F, A); chunk_pass1<128, true>(F, P, 8, F.vcu); }
__device__ __forceinline__ void p14_mix1_scan(Frame& F, const Args& A) { const ChunkP P = hgrn_params(F, A); chunk_scan(F, P.kv, P.dec, 64, 128); }
__device__ __forceinline__ void p15_mix1_pass2(Frame& F, const Args& A) { const ChunkP P = hgrn_params(F, A); chunk_pass2<128, true>(F, P, 8, 4, F.vcu); }
__device__ __forceinline__ void p16_outproj1(Frame& F, const Args& A) {
    SchedPlain S{(const bf16*)(F.ws + WS_B + B_Y1), (const bf16*)(F.ws + WS_W_OUT1), D, NB * SEQ / 256, D / 256, F.G, (int)blockIdx.x, 1};
    EpiPlain E{(bf16*)(F.ws + WS_A + A_O), D};
    pg8::gemm_phase<EpiPlain, SchedPlain>(F.lds, D, S, E);
}

__global__ void __launch_bounds__(NWAVES * 64, 2) mk_fwd(Args args) {
    extern __shared__ __attribute__((aligned(16))) unsigned char lds[];
    Frame F;
    F.lds = (LAS unsigned char*)lds;
    F.MISC = (volatile LAS unsigned*)(F.lds + MISC_OFF);
    F.tid = threadIdx.x; F.lane = F.tid & 63; F.wave = __builtin_amdgcn_readfirstlane(F.tid >> 6);
    F.G = gridDim.x; { const int bx = blockIdx.x; F.vcu = (F.G % 8 == 0) ? (bx % 8) * (F.G / 8) + bx / 8 : bx; }
    F.ws = args.ws; F.out = args.out;
    F.ctl = (gu32*)(args.ws + WS_CTL);
    if (F.tid < 32) F.MISC[F.tid] = 0u;
    __syncthreads();
    const int lo = args.ph_lo, hi = args.ph_hi;
    XcdBarrier bar; bar.bar = (unsigned*)(F.ctl + CW_BAR); bar.x = 0; bar.st = nullptr;
    if (hi - lo > 1) bar = xcd_barrier_post((unsigned*)(F.ctl + CW_BAR), F.MISC + 8);
#define IN(k) (lo <= (k) && (k) < hi)
#define SEAM(k) do { if (IN(k) && IN((k) + 1)) xcd_barrier(bar); } while (0)
#define RUNPH(k, call) do { if (IN(k)) { const __attribute__((address_space(4))) Args* ap4_ = (const __attribute__((address_space(4))) Args*)__builtin_amdgcn_kernarg_segment_ptr(); \
        asm volatile("" : "+s"(ap4_)); const Args& args = *(const Args*)ap4_; asm volatile("" : "+v"(F.lane)); call; } } while (0)
    RUNPH(0, p0_prep(F, args));
    SEAM(0);
    RUNPH(1, p1_prenorm0(F, args));
    SEAM(1);
    RUNPH(2, p2_inproj0(F, args));
    SEAM(2);
        RUNPH(3, p3_mix0_pass1(F, args));
    SEAM(3);
    RUNPH(4, p4_mix0_scan(F, args));
    SEAM(4);
    RUNPH(5, p5_mix0_pass2(F, args));
    SEAM(5);
    RUNPH(6, p6_outproj0(F, args));
    SEAM(6);
    RUNPH(7, p7_post(F, args, 0));
    if (IN(7) && IN(9)) xcd_barrier(bar);
    RUNPH(9, p9_gemm1<0>(F, args));
    SEAM(9);
    RUNPH(10, p10_gemm2<0>(F, args));
    SEAM(10);
    RUNPH(11, p11_combine<0>(F, args));
    SEAM(11);
    RUNPH(12, p12_inproj1(F, args));
    SEAM(12);
    RUNPH(13, p13_mix1_pass1(F, args));
    SEAM(13);
    RUNPH(14, p14_mix1_scan(F, args));
    SEAM(14);
    RUNPH(15, p15_mix1_pass2(F, args));
    SEAM(15);
    RUNPH(16, p16_outproj1(F, args));
    SEAM(16);
    RUNPH(17, p7_post(F, args, 1));
    if (IN(17) && IN(19)) xcd_barrier(bar);
    RUNPH(19, p9_gemm1<1>(F, args));
    SEAM(19);
    RUNPH(20, p10_gemm2<1>(F, args));
    SEAM(20);
    RUNPH(21, p11_combine<1>(F, args));

    for (int xb_ = 0; xb_ < MK_XBAR; ++xb_) xcd_barrier(bar);
#undef IN
#undef SEAM
#undef RUNPH
}

static inline unsigned cdiv(size_t a, size_t b) { return (unsigned)((a + b - 1) / b); }
#if MK_DEBUG
constexpr int NSAMP = 128, SSTRIDE = 131;
constexpr size_t DBG_FINAL = 0;
constexpr size_t DBG_SAMP = (size_t)NB * SEQ * D * 2;
constexpr size_t SLOT_BYTES = (size_t)NSAMP * 2048 * 4;
__global__ void dk_sample(const float* src, int ld, int ncols, float* dst) {
    const int i = blockIdx.x; const size_t row = (size_t)SSTRIDE * i;
    for (int c = threadIdx.x; c < ncols; c += 256) dst[(size_t)i * ncols + c] = src[row * ld + c];
}
__global__ void dk_sample_stream(const float* xl, const float* xc, float* dst) {
    const int i = blockIdx.x; const int row = SSTRIDE * i;
    const float* src = row_src(xl, xc, row);
    for (int c = threadIdx.x; c < D; c += 256) dst[(size_t)i * D + c] = src[c];
}
__global__ void dk_save_bf16(const float* src, bf16* dst, size_t n) { const size_t i = (size_t)blockIdx.x * 256 + threadIdx.x; if (i < n) dst[i] = (bf16)f2bf(src[i]); }
__global__ void dk_cmp(const void* fast, const void* fast2, int dtype, int ldf, int rowmode, const float* samp, int ncols, int xform, float* err, int id) {
    __shared__ float rn[16], rd[16];
    float num = 0.f, den = 0.f;
    for (int i = 0; i < NSAMP; ++i) {
        const int row = SSTRIDE * i; int frow = row;
        if ((rowmode == 5 || rowmode == 6 || rowmode == 7) && (row % T) < CTX) continue;
        if (rowmode == 1 || rowmode == 5) { const int b = row / T, s = row % T; if (s >= CTX) { const int t = s - CTX, r = t >> 6, c = t & 63; frow = b * T + CTX + c * 64 + r; } }
        for (int c = threadIdx.x; c < ncols; c += 1024) {
            float o = (rowmode == 3) ? samp[(size_t)i * 2 * ncols + ncols + c] : ((rowmode == 4) ? samp[(size_t)i * 2 * ncols + c] : samp[(size_t)i * ncols + c]);
            if (xform == 1) o = gelu_tanh(o); else if (xform == 2) o = siluf(o);
            float f;
            if (rowmode == 2 || rowmode == 6) { f = row_src((const float*)fast, (const float*)fast2, row)[c]; }
            else if (dtype == 0) f = bf2f(((const bf16*)fast)[(size_t)frow * ldf + c]);
            else if (dtype == 1) f = h2f(((const f16b*)fast)[(size_t)frow * ldf + c]);
            else f = ((const float*)fast)[(size_t)frow * ldf + c];
            const float d = f - o; num += d * d; den += o * o;
            if (!(d == d)) num += 1e30f;
        }
    }
    num = wave_sum(num); den = wave_sum(den);
    if ((threadIdx.x & 63) == 0) { rn[threadIdx.x >> 6] = num; rd[threadIdx.x >> 6] = den; }
    __syncthreads();
    if (threadIdx.x == 0) { float a = 0.f, b = 0.f; for (int w = 0; w < 16; ++w) { a += rn[w]; b += rd[w]; } err[2 * id] = a; err[2 * id + 1] = b; }
}
__global__ void dk_cmp_flat(const float* fast, const float* ref, int n, float* err, int id) {
    __shared__ float rn[16], rd[16];
    float num = 0.f, den = 0.f;
    for (int i = threadIdx.x; i < n; i += 1024) { const float d = fast[i] - ref[i]; num += d * d; den += ref[i] * ref[i]; if (!(d == d)) num += 1e30f; }
    num = wave_sum(num); den = wave_sum(den);
    if ((threadIdx.x & 63) == 0) { rn[threadIdx.x >> 6] = num; rd[threadIdx.x >> 6] = den; }
    __syncthreads();
    if (threadIdx.x == 0) { float a = 0.f, b = 0.f; for (int w = 0; w < 16; ++w) { a += rn[w]; b += rd[w]; } err[2 * id] = a; err[2 * id + 1] = b; }
}
__global__ void dk_verdict(const float* err, int nid, float thr, int* code_out) {
    if (threadIdx.x == 0 && blockIdx.x == 0) { int code = 0, big = 0;
        for (int i = 0; i < nid; ++i) { const float r = err[2 * i] / fmaxf(err[2 * i + 1], 1e-30f); if (!(r <= thr)) { code = i + 1; big = !(r <= 0.1f); break; } }
        code_out[0] = code; code_out[1] = big; }
}
__global__ void dk_emit(const int* code, const bf16* oracle_final, float* out, size_t n, int full) {
    const int c = code[0]; if (c == 0 && full) return;
    const size_t nz = (size_t)((0.02 * c + 0.01 * code[1]) * (double)n);
    const size_t i = (size_t)blockIdx.x * 256 + threadIdx.x; if (i < n) out[i] = i < nz ? 0.f : bf2f(oracle_final[i]);
}
static void ogemm(hipStream_t st, const float* A, int lda, const float* B, int ldb, float* C, int ldc, int M, int N, int K) {
    hipLaunchKernelGGL(nv::k_gemm, dim3(cdiv(N, 64), cdiv(M, 64)), dim3(256), 0, st, A, lda, B, ldb, C, ldc, M, N, K);
}
enum { S_MOD = 0, S_H0, S_CL0, S_CL1, S_Q, S_K, S_V, S_CL5, S_ALR, S_Y0, S_O0, S_X1, S_HM0, S_LG0, S_F0, S_X2, S_H1, S_Q1, S_ZF, S_ZB, S_V1, S_CL4, S_Y1, S_O1, S_X3, S_HM1, S_F1, S_OUT, S_NSLOT };
static void run_debug(Args a, void* const* d_in, void* d_out, void* d_ws, size_t ws_size, hipStream_t st, int grid) {
    const float* x = (const float*)d_in[0]; const float* c = (const float*)d_in[1]; const float* ctx = (const float*)d_in[2]; const float* c_ctx = (const float*)d_in[3];
    const float* mod_w = (const float*)d_in[4]; const float* mod_b = (const float*)d_in[5]; const float* pre_gain = (const float*)d_in[6]; const float* post_gain = (const float*)d_in[7];
    const float* ab_w_in = (const float*)d_in[8]; const float* ab_conv_w = (const float*)d_in[9]; const float* ab_conv_b = (const float*)d_in[10];
    const float* lru_wa = (const float*)d_in[11]; const float* lru_ba = (const float*)d_in[12]; const float* lru_wi = (const float*)d_in[13]; const float* lru_bi = (const float*)d_in[14];
    const float* lru_lam = (const float*)d_in[15]; const float* gla_wa2 = (const float*)d_in[16]; const float* gla_ba = (const float*)d_in[17]; const float* ab_w_out = (const float*)d_in[18];
    const float* c_w_in = (const float*)d_in[19]; const float* lb_logits = (const float*)d_in[20]; const float* c_w_out = (const float*)d_in[21];
    const float* router = (const float*)d_in[22]; const float* moe_bias = (const float*)d_in[23]; const float* w_gate = (const float*)d_in[24]; const float* w_up = (const float*)d_in[25];
    const float* w_down = (const float*)d_in[26]; const float* ws_gate = (const float*)d_in[27]; const float* ws_up = (const float*)d_in[28]; const float* ws_down = (const float*)d_in[29];
    float* out = (float*)d_out;
    unsigned char* wsb = (unsigned char*)d_ws;
    if (ws_size < WS_DBG + DBG_SAMP + S_NSLOT * SLOT_BYTES) { fprintf(stderr, "debug: workspace too small\n"); return; }
    bf16* dbg_final = (bf16*)(wsb + WS_DBG + DBG_FINAL);
    auto slot = [&](int s) { return (float*)(wsb + WS_DBG + DBG_SAMP + (size_t)s * SLOT_BYTES); };
    auto samp = [&](const float* src, int ld, int ncols, int s) { hipLaunchKernelGGL(dk_sample, dim3(NSAMP), dim3(256), 0, st, src, ld, ncols, slot(s)); };
    const size_t RD = (size_t)R * D;
    float* W = (float*)d_ws; size_t off = 0;
    auto take = [&](size_t n) { float* p = W + off; off += (n + 63) & ~(size_t)63; return p; };
    float* Mm = take(2 * 5 * NMOD);
    float* ctxb = take((size_t)NB * CTX * D);
    float* H = take(RD); float* A = take(RD); float* B = take(RD); float* C = take(RD); float* Dd = take(RD); float* E = take(2 * RD);
    float* lg = take((size_t)R * NE); float* alr = take((size_t)R * 32);
    int* tk_e = (int*)take((size_t)R * TOPK); float* tk_w = take((size_t)R * TOPK); int* cnt = (int*)take(64); int* list = (int*)take((size_t)NE * R);
    if (off * 4 > WS_DBG) { fprintf(stderr, "debug: oracle workspace overlaps the checkpoint region\n"); return; }
    const unsigned gRD = cdiv(RD, 256);

    hipLaunchKernelGGL(nv::k_mod, dim3(NMOD / 256, 5, 2), dim3(256), 0, st, c, c_ctx, mod_w, mod_b, Mm);
    (void)hipMemcpyAsync(slot(S_MOD), Mm, (size_t)2 * 5 * NMOD * 4, hipMemcpyDeviceToDevice, st);
    {
        const float* Ml = Mm;
        hipLaunchKernelGGL(nv::k_prenorm, dim3(R), dim3(256), 0, st, x, ctx, pre_gain + 0, Ml, 0, 1, H, 0);
        samp(H, D, D, S_H0);
        ogemm(st, H, D, ab_w_in + 1024, ABC, A, D, R, 1024, D);   samp(A, D, D, S_CL1);
        hipLaunchKernelGGL(nv::k_conv, dim3(gRD), dim3(256), 0, st, A, ab_conv_w, ab_conv_b, B);
        for (int d = 0; d < 2; ++d) {
            for (int h = 0; h < 8; ++h) {
                ogemm(st, B + h * 128, D, lru_wa + ((size_t)d * 8 + h) * 128 * 128, 128, A + h * 128, D, R, 128, 128);
                ogemm(st, B + h * 128, D, lru_wi + ((size_t)d * 8 + h) * 128 * 128, 128, C + h * 128, D, R, 128, 128);
            }
            hipLaunchKernelGGL(nv::k_lru_gate, dim3(gRD), dim3(256), 0, st, A, C, B, lru_ba + d * D, lru_bi + d * D, lru_lam + d * D);
            hipLaunchKernelGGL(nv::k_lru_scan, dim3(NB * D / 256), dim3(256), 0, st, A, C, Dd, d, d);
        }
        ogemm(st, H, D, ab_w_in + 0, ABC, A, D, R, 1024, D);   samp(A, D, D, S_CL0);
        hipLaunchKernelGGL(nv::k_ya, dim3(gRD), dim3(256), 0, st, A, Dd, E, 2 * D);
        float* q = A; float* k = A + (size_t)R * 512;
        ogemm(st, H, D, ab_w_in + 2048, ABC, q, 512, R, 512, D);
        hipLaunchKernelGGL(nv::k_scale, dim3(cdiv((size_t)R * 512, 256)), dim3(256), 0, st, q, (size_t)R * 512, 0.08838834764831845f);
        samp(q, 512, 512, S_Q);
        ogemm(st, H, D, ab_w_in + 2560, ABC, k, 512, R, 512, D);   samp(k, 512, 512, S_K);
        ogemm(st, H, D, ab_w_in + 3072, ABC, B, D, R, 1024, D);    samp(B, D, D, S_V);
        ogemm(st, H, D, ab_w_in + 5120, ABC, alr, 32, R, 32, D);   samp(alr, 32, 32, S_ALR);
        for (int d = 0; d < 2; ++d) {
            float* g = C + (size_t)d * R * 512;
            ogemm(st, alr + d * 16, 32, gla_wa2 + (size_t)d * 16 * 512, 512, g, 512, R, 512, 16);
            hipLaunchKernelGGL(nv::k_gla_gate, dim3(cdiv((size_t)R * 512, 256)), dim3(256), 0, st, g, gla_ba + d * 512, 512);
            hipLaunchKernelGGL(nv::k_gla_scan<256>, dim3(256 / 8, 4, NB), dim3(1024), 0, st, q, 512, k, 512, B, D, g, 512, Dd, D, d, 0, d);
        }
        ogemm(st, H, D, ab_w_in + 4096, ABC, A, D, R, 1024, D);   samp(A, D, D, S_CL5);
        hipLaunchKernelGGL(nv::k_yb<256>, dim3(cdiv((size_t)R * 4 * 64, 256)), dim3(256), 0, st, Dd, A, D, E + D, 2 * D, 4);
        samp(E, 2 * D, 2 * D, S_Y0);
        ogemm(st, E, 2 * D, ab_w_out, D, A, D, R, D, 2 * D);   samp(A, D, D, S_O0);
        hipLaunchKernelGGL(nv::k_postres, dim3(R), dim3(256), 0, st, x, ctx, out, ctxb, A, post_gain + 0, Ml, 2, 0, 0);
        hipLaunchKernelGGL(dk_sample_stream, dim3(NSAMP), dim3(256), 0, st, out, ctxb, slot(S_X1));
        hipLaunchKernelGGL(nv::k_prenorm, dim3(R), dim3(256), 0, st, out, ctxb, pre_gain + D, Ml, 3, 4, H, 0);   samp(H, D, D, S_HM0);
        ogemm(st, H, D, router, NE, lg, NE, R, NE, D);   samp(lg, NE, NE, S_LG0);
        (void)hipMemsetAsync(cnt, 0, 64 * sizeof(int), st);
        hipLaunchKernelGGL(nv::k_route, dim3(cdiv((size_t)R * 64, 256)), dim3(256), 0, st, lg, moe_bias, R, tk_e, tk_w, cnt, list);
        hipLaunchKernelGGL(nv::k_expert, dim3(R / 8), dim3(256), 0, st, H, 0, R, ws_gate, ws_up, ws_down, cnt, list, tk_w, NE, A, 1);
        for (int e = 0; e < NE; ++e)
            hipLaunchKernelGGL(nv::k_expert, dim3(R / 8), dim3(256), 0, st, H, 0, R, w_gate + (size_t)e * D * FF, w_up + (size_t)e * D * FF, w_down + (size_t)e * FF * D, cnt, list, tk_w, e, A, 0);
        samp(A, D, D, S_F0);
        hipLaunchKernelGGL(nv::k_postres, dim3(R), dim3(256), 0, st, out, ctxb, out, ctxb, A, post_gain + D, Ml, 5, 0, 0);
        hipLaunchKernelGGL(dk_sample_stream, dim3(NSAMP), dim3(256), 0, st, out, ctxb, slot(S_X2));
    }
    {
        const float* Ml = Mm + 5 * NMOD;
        hipLaunchKernelGGL(nv::k_prenorm, dim3(R), dim3(256), 0, st, out, ctxb, pre_gain + 2 * D, Ml, 0, 1, H, 0);   samp(H, D, D, S_H1);
        ogemm(st, H, D, c_w_in + 0, CC, A, D, R, 1024, D);      samp(A, D, D, S_Q1);
        ogemm(st, H, D, c_w_in + 3072, CC, B, D, R, 1024, D);   samp(B, D, D, S_V1);
        for (int d = 0; d < 2; ++d) {
            ogemm(st, H, D, c_w_in + 1024 * (1 + d), CC, C, D, R, 1024, D);   samp(C, D, D, d ? S_ZB : S_ZF);
            hipLaunchKernelGGL(nv::k_hgrn_gate, dim3(gRD), dim3(256), 0, st, C, D, lb_logits, E, E + RD);
            hipLaunchKernelGGL(nv::k_gla_scan<128>, dim3(128 / 8, 8, NB), dim3(1024), 0, st, A, D, E + RD, D, B, D, E, D, Dd, D, d, 1, d);
        }
        ogemm(st, H, D, c_w_in + 4096, CC, C, D, R, 1024, D);   samp(C, D, D, S_CL4);
        hipLaunchKernelGGL(nv::k_yb<128>, dim3(cdiv((size_t)R * 8 * 64, 256)), dim3(256), 0, st, Dd, C, D, E, D, 8);   samp(E, D, D, S_Y1);
        ogemm(st, E, D, c_w_out, D, A, D, R, D, D);   samp(A, D, D, S_O1);
        hipLaunchKernelGGL(nv::k_postres, dim3(NB * SEQ), dim3(256), 0, st, out, ctxb, out, ctxb, A, post_gain + 2 * D, Ml, 2, 0, 1);
        hipLaunchKernelGGL(dk_sample_stream, dim3(NSAMP), dim3(256), 0, st, out, ctxb, slot(S_X3));
        hipLaunchKernelGGL(nv::k_prenorm, dim3(R), dim3(256), 0, st, out, ctxb, pre_gain + 3 * D, Ml, 3, 4, H, 0);   samp(H, D, D, S_HM1);
        for (int b = 0; b < NB; ++b) (void)hipMemcpyAsync(C + (size_t)b * SEQ * D, H + ((size_t)b * T + CTX) * D, (size_t)SEQ * D * 4, hipMemcpyDeviceToDevice, st);
        const int NT = NB * SEQ;
        ogemm(st, C, D, router + (size_t)D * NE, NE, lg, NE, NT, NE, D);
        (void)hipMemsetAsync(cnt, 0, 64 * sizeof(int), st);
        hipLaunchKernelGGL(nv::k_route, dim3(cdiv((size_t)NT * 64, 256)), dim3(256), 0, st, lg, moe_bias + NE, NT, tk_e, tk_w, cnt, list);
        const size_t WE = (size_t)NE * D * FF;
        hipLaunchKernelGGL(nv::k_expert, dim3(NT / 8), dim3(256), 0, st, C, 0, NT, ws_gate + (size_t)D * FF, ws_up + (size_t)D * FF, ws_down + (size_t)FF * D, cnt, list, tk_w, NE, A, 1);
        for (int e = 0; e < NE; ++e)
            hipLaunchKernelGGL(nv::k_expert, dim3(NT / 8), dim3(256), 0, st, C, 0, NT, w_gate + WE + (size_t)e * D * FF, w_up + WE + (size_t)e * D * FF, w_down + WE + (size_t)e * FF * D, cnt, list, tk_w, e, A, 0);
        for (int b = 0; b < NB; ++b) (void)hipMemcpyAsync(B + ((size_t)b * T + CTX) * D, A + (size_t)b * SEQ * D, (size_t)SEQ * D * 4, hipMemcpyDeviceToDevice, st);
        samp(B, D, D, S_F1);
        hipLaunchKernelGGL(nv::k_postres, dim3(NB * SEQ), dim3(256), 0, st, out, ctxb, out, ctxb, B, post_gain + 3 * D, Ml, 5, 0, 1);
        hipLaunchKernelGGL(dk_sample_stream, dim3(NSAMP), dim3(256), 0, st, out, ctxb, slot(S_OUT));
    }
    hipLaunchKernelGGL(dk_save_bf16, dim3(cdiv((size_t)NB * SEQ * D, 256)), dim3(256), 0, st, out, dbg_final, (size_t)NB * SEQ * D);

    (void)hipMemsetAsync((char*)d_ws + WS_CTL, 0, CTL_ZERO_BYTES, st);
    float* err = (float*)(wsb + WS_CTL) + CW_DBG; int* code = (int*)(wsb + WS_CTL) + CW_DBG + 512;
    int nid = 0;
    auto cmp = [&](const void* fast, int dtype, int ldf, int rowmode, int s, int ncols, int xform) {
        hipLaunchKernelGGL(dk_cmp, dim3(1), dim3(1024), 0, st, fast, (const void*)(wsb + WS_CTXB), dtype, ldf, rowmode, (const float*)slot(s), ncols, xform, err, nid); ++nid; };
    unsigned char* aA = wsb + WS_A; unsigned char* aB = wsb + WS_B;
    for (int p = 0; p < MK_NPHASE; ++p) {
        a.ph_lo = p; a.ph_hi = p + 1;
        hipLaunchKernelGGL(mk_fwd, dim3(grid), dim3(NWAVES * 64), LDS_BYTES, st, a);
        switch (p) {
        case 0: hipLaunchKernelGGL(dk_cmp_flat, dim3(1), dim3(1024), 0, st, (const float*)(wsb + WS_MOD), (const float*)slot(S_MOD), 2 * 5 * NMOD, err, nid); ++nid; break;
        case 1: cmp(aB + B_H0, 0, D, 0, S_H0, D, 0); break;
        case 2: cmp(aA + A_GX, 0, D, 0, S_CL0, D, 1); cmp(aA + A_XL, 0, D, 0, S_CL1, D, 0); cmp(aA + A_Q, 0, 512, 0, S_Q, 512, 0); cmp(aA + A_K, 0, 512, 0, S_K, 512, 0);
                cmp(aA + A_V, 0, D, 0, S_V, D, 0); cmp(aA + A_SG, 0, D, 0, S_CL5, D, 2); cmp(aA + A_ALR, 1, 32, 0, S_ALR, 32, 0); break;
                case 5: cmp(aB + B_Y, 0, 2 * D, 4, S_Y0, D, 0);
                hipLaunchKernelGGL(dk_cmp, dim3(1), dim3(1024), 0, st, (const void*)(aB + B_Y + (size_t)D * 2), (const void*)nullptr, 0, 2 * D, 3, (const float*)slot(S_Y0), D, 0, err, nid); ++nid; break;
        case 6: cmp(aA + A_O, 0, D, 0, S_O0, D, 0); break;
        case 7: cmp(d_out, 2, D, 2, S_X1, D, 0); break;
        case 8: break;
        case 9: break;
        case 10: break;
        case 11: cmp(d_out, 2, D, 2, S_X2, D, 0); cmp(aB + B_H1, 0, D, 1, S_H1, D, 0); break;
        case 12: cmp(aA + A_Q1, 0, D, 1, S_Q1, D, 0); cmp(aA + A_ZF, 1, D, 1, S_ZF, D, 0); cmp(aA + A_ZB, 1, D, 1, S_ZB, D, 0); cmp(aA + A_V1, 0, D, 1, S_V1, D, 0); cmp(aA + A_SG1, 0, D, 1, S_CL4, D, 2); break;
        case 15: hipLaunchKernelGGL(dk_cmp, dim3(1), dim3(1024), 0, st, (const void*)(aB + B_Y1), (const void*)nullptr, 0, D, 5, (const float*)slot(S_Y1), D, 0, err, nid); ++nid; break;
        case 16: hipLaunchKernelGGL(dk_cmp, dim3(1), dim3(1024), 0, st, (const void*)(aA + A_O), (const void*)nullptr, 0, D, 5, (const float*)slot(S_O1), D, 0, err, nid); ++nid; break;
        case 17: hipLaunchKernelGGL(dk_cmp, dim3(1), dim3(1024), 0, st, (const void*)d_out, (const void*)(wsb + WS_CTXB), 2, D, 6, (const float*)slot(S_X3), D, 0, err, nid); ++nid;
                 break;
        case 21: hipLaunchKernelGGL(dk_cmp, dim3(1), dim3(1024), 0, st, (const void*)d_out, (const void*)(wsb + WS_CTXB), 2, D, 6, (const float*)slot(S_OUT), D, 0, err, nid); ++nid; break;

        default: break;
        }
    }
    hipLaunchKernelGGL(dk_verdict, dim3(1), dim3(64), 0, st, err, nid, MK_DEBUG_THR, code);
    hipLaunchKernelGGL(dk_emit, dim3(cdiv((size_t)NB * SEQ * D, 256)), dim3(256), 0, st, code, dbg_final, out, (size_t)NB * SEQ * D, MK_DEBUG_FULL);
}

#endif

extern "C" void kernel_launch(void* const* d_in, const int* in_sizes, int n_in, void* d_out, int out_size, void* d_ws, size_t ws_size, hipStream_t stream) {
    static int grid = 0;
    if (grid == 0) {
        if (n_in != 30 || out_size != NB * SEQ * D || ws_size < WS_END_PROD) { fprintf(stderr, "kernel_launch: bad sizes (n_in %d out %d ws %zu < %zu)\n", n_in, out_size, ws_size, (size_t)WS_END_PROD); grid = -1; return; }
        int dev = 0, cus = 0;
        if (hipGetDevice(&dev) != hipSuccess || hipDeviceGetAttribute(&cus, hipDeviceAttributeMultiprocessorCount, dev) != hipSuccess) { grid = -1; return; }
        if (hipFuncSetAttribute((const void*)mk_fwd, hipFuncAttributeMaxDynamicSharedMemorySize, LDS_BYTES) != hipSuccess) { fprintf(stderr, "kernel_launch: hipFuncSetAttribute failed\n"); grid = -1; return; }
        int per_cu = 0;
        if (hipOccupancyMaxActiveBlocksPerMultiprocessor(&per_cu, (const void*)mk_fwd, NWAVES * 64, LDS_BYTES) != hipSuccess || per_cu < 1) { fprintf(stderr, "kernel_launch: occupancy query says %d blocks/CU\n", per_cu); }
        (void)hipGetLastError();
        grid = cus;
    }
    if (grid < 0) return;
    Args a{};
    for (int i = 0; i < 30; ++i) a.in[i] = (const float*)d_in[i];
    a.out = (float*)d_out; a.ws = (unsigned char*)d_ws;
#if MK_DEBUG
    run_debug(a, d_in, d_out, d_ws, ws_size, stream, grid);
#else
    (void)hipMemsetAsync((char*)d_ws + WS_CTL, 0, CTL_ZERO_BYTES, stream);
    { const int pre[] = {MK_PRE -1};
      int npre = 0; for (int i = 0; pre[i] >= 0; ++i) { a.ph_lo = pre[i]; a.ph_hi = pre[i] + 1; a.abl = MK_ABL; hipLaunchKernelGGL(mk_fwd, dim3(grid), dim3(NWAVES * 64), LDS_BYTES, stream, a); ++npre; }
      a.abl = 0;
      if (npre) (void)hipMemsetAsync((char*)d_ws + WS_CTL, 0, CTL_ZERO_BYTES, stream); }
    a.ph_lo = 0; a.ph_hi = MK_NPHASE;
    hipLaunchKernelGGL(mk_fwd, dim3(grid), dim3(NWAVES * 64), LDS_BYTES, stream, a);
    { const int extra[] = {MK_EXTRA -1};
      for (int i = 0; extra[i] >= 0; ++i) { a.ph_lo = extra[i]; a.ph_hi = extra[i] + 1; a.abl = MK_ABL; hipLaunchKernelGGL(mk_fwd, dim3(grid), dim3(NWAVES * 64), LDS_BYTES, stream, a); } }
#endif
}
```
